# Optimizing an MI355X kernel written in HIP

```python
import math
import jax
import jax.numpy as jnp
from jax import lax
import numpy as np

D_MODEL = 2048
BATCH = 2
SEQ = 4096
DEPTH = 4

GRID_W = 64
CTX_LEN = 256
N_MIXERS = 3
EPS = 1e-6
ROPE_BASE = 10000.0
N_MOD = 6

DA_HEAD_DIM = 128
DA_HEADS = D_MODEL // (2 * DA_HEAD_DIM)
DA_WIDTH = 2 * DA_HEADS * DA_HEAD_DIM
DA_Q_BLOCK = 128

SG_CHUNK = 128
SG_GROUP_DIM = 128
SG_WIDTH = D_MODEL
SG_GROUPS = SG_WIDTH // SG_GROUP_DIM

RET_HEADS = D_MODEL // 256
RET_KEY_DIM = D_MODEL // RET_HEADS
RET_VAL_DIM = 2 * D_MODEL // RET_HEADS
RET_CHUNK = 128

FFN_HIDDEN = -((-8 * D_MODEL) // (3 * 256)) * 256

kernel_name = 'hybrid_diffattn_sgmlp_retention_dit'


def rms_norm(x, gain=None):
    xf = x.astype(jnp.float32)
    y = (xf * lax.rsqrt(jnp.mean(xf * xf, axis=-1, keepdims=True) + EPS)).astype(x.dtype)
    return y if gain is None else y * gain


def modulate(h, shift, scale):
    return h * (1.0 + scale) + shift


def axial_rope_tables(n_tokens, head_dim, dtype):
    rows = n_tokens // GRID_W
    row = jnp.broadcast_to(jnp.arange(rows)[:, None], (rows, GRID_W)).reshape(-1).astype(jnp.float32)
    col = jnp.broadcast_to(jnp.arange(GRID_W)[None, :], (rows, GRID_W)).reshape(-1).astype(jnp.float32)
    n_freq = head_dim // 4
    inv_freq = ROPE_BASE ** (-jnp.arange(n_freq, dtype=jnp.float32) / n_freq)
    ang = jnp.concatenate([row[:, None] * inv_freq, col[:, None] * inv_freq], axis=-1)
    return jnp.cos(ang).astype(dtype), jnp.sin(ang).astype(dtype)


def apply_rope(x, cos, sin):
    shape = (x.shape[1],) + (1,) * (x.ndim - 3) + (cos.shape[-1],)
    cos = cos.reshape(shape)
    sin = sin.reshape(shape)
    x1, x2 = jnp.split(x, 2, axis=-1)
    return jnp.concatenate([x1 * cos - x2 * sin, x1 * sin + x2 * cos], axis=-1)


def swiglu(h, w_gate_up, w_down):
    a, g = jnp.split(h @ w_gate_up, 2, axis=-1)
    return (jax.nn.silu(a) * g) @ w_down


def diff_attn_core(q, k, v, lam, scale):
    s = jnp.einsum('bqhmd,bkhmd->bhmqk', q, k).astype(jnp.float32) * scale
    p = jax.nn.softmax(s, axis=-1)
    p_diff = p[:, :, 0] - lam * p[:, :, 1]
    return jnp.einsum('bhqk,bkhe->bqhe', p_diff.astype(v.dtype), v)


def diff_attention_mixer(hx, hc, w_qkv, w_o, lam_vecs, subln_g, lambda_init, cos, sin, need_ctx):
    def proj(h):
        b, n, _ = h.shape
        q, k, v = jnp.split(h @ w_qkv, 3, axis=-1)
        return (q.reshape(b, n, DA_HEADS, 2, DA_HEAD_DIM),
                k.reshape(b, n, DA_HEADS, 2, DA_HEAD_DIM),
                v.reshape(b, n, DA_HEADS, 2 * DA_HEAD_DIM))

    qx, kx, vx = proj(hx)
    qc, kc, vc = proj(hc)
    qx = apply_rope(qx, cos, sin)
    kx = apply_rope(kx, cos, sin)
    lv = lam_vecs.astype(jnp.float32)
    lam = jnp.exp(jnp.sum(lv[0] * lv[1])) - jnp.exp(jnp.sum(lv[2] * lv[3])) + lambda_init
    scale = DA_HEAD_DIM ** -0.5

    k_all = jnp.concatenate([kc, kx], axis=1)
    v_all = jnp.concatenate([vc, vx], axis=1)
    b, n = qx.shape[0], qx.shape[1]
    nb = n // DA_Q_BLOCK
    qb = qx.reshape(b, nb, DA_Q_BLOCK, DA_HEADS, 2, DA_HEAD_DIM).swapaxes(0, 1)
    ox = lax.map(lambda qq: diff_attn_core(qq, k_all, v_all, lam, scale), qb)
    ox = ox.swapaxes(0, 1).reshape(b, n, DA_HEADS, 2 * DA_HEAD_DIM)

    def finish(o):
        bb, nn = o.shape[0], o.shape[1]
        o = rms_norm(o, subln_g) * (1.0 - lambda_init)
        return o.reshape(bb, nn, DA_WIDTH) @ w_o

    yx = finish(ox)
    yc = finish(diff_attn_core(qc, kc, vc, lam, scale)) if need_ctx else None
    return yx, yc


def spatial_gating_mixer(h, w_in, v_gain, w_s, b_s, w_out):
    b, n, _ = h.shape
    z = jax.nn.gelu(h @ w_in, approximate=False)
    u, v = jnp.split(z, 2, axis=-1)
    v = rms_norm(v, v_gain)
    v = v.reshape(b, n // SG_CHUNK, SG_CHUNK, SG_GROUPS, SG_GROUP_DIM)
    v = jnp.einsum('gpq,bcqgd->bcpgd', w_s, v) + b_s.T[:, :, None]
    return (u * v.reshape(b, n, SG_WIDTH)) @ w_out


def retention_chunk_scan(q, k, v, log_gamma, state0):
    b, n, h, _ = q.shape
    dv = v.shape[-1]
    nc = n // RET_CHUNK

    def chunks(t):
        return t.reshape(b, nc, RET_CHUNK, h, t.shape[-1]).transpose(1, 0, 3, 2, 4)

    pos = jnp.arange(RET_CHUNK, dtype=jnp.float32)
    dist = pos[:, None] - pos[None, :]
    decay = jnp.where(dist >= 0, jnp.exp(log_gamma[:, None, None] * jnp.maximum(dist, 0.0)), 0.0)
    xi = jnp.exp(log_gamma[:, None] * (pos + 1.0))[..., None]
    zeta = jnp.exp(log_gamma[:, None] * (RET_CHUNK - 1.0 - pos))[..., None]
    g_chunk = jnp.exp(log_gamma * RET_CHUNK)[:, None, None]

    def step(s, qkv):
        qc, kc, vc = qkv
        scores = jnp.einsum('bhqd,bhkd->bhqk', qc, kc) * decay
        o = jnp.einsum('bhqk,bhke->bhqe', scores, vc) + jnp.einsum('bhqd,bhde->bhqe', qc, s) * xi
        s = g_chunk * s + jnp.einsum('bhkd,bhke->bhde', kc * zeta, vc)
        return s, o.astype(jnp.float32)

    s_final, o = lax.scan(step, state0, (chunks(q), chunks(k), chunks(v)))
    o = o.transpose(1, 0, 3, 2, 4).reshape(b, n, h, dv)
    return o, s_final


def retention_mixer(hx, hc, w_q, w_k, w_v, w_g, w_o, decay_param, cos, sin, need_ctx):
    log_gamma = -jnp.exp(decay_param.astype(jnp.float32))

    def proj(h):
        b, n, _ = h.shape
        q = (h @ w_q).reshape(b, n, RET_HEADS, RET_KEY_DIM)
        k = (h @ w_k).reshape(b, n, RET_HEADS, RET_KEY_DIM) * (RET_KEY_DIM ** -0.5)
        v = (h @ w_v).reshape(b, n, RET_HEADS, RET_VAL_DIM)
        return q, k, v

    qx, kx, vx = proj(hx)
    qx = apply_rope(qx, cos, sin)
    kx = apply_rope(kx, cos, sin)
    qc, kc, vc = proj(hc)
    s0 = jnp.zeros((hx.shape[0], RET_HEADS, RET_KEY_DIM, RET_VAL_DIM), jnp.float32)

    def flip(t):
        return jnp.flip(t, axis=1)

    oc_f, sc_f = retention_chunk_scan(qc, kc, vc, log_gamma[0], s0)
    oc_b, sc_b = retention_chunk_scan(flip(qc), flip(kc), flip(vc), log_gamma[1], s0)
    ox_f, _ = retention_chunk_scan(qx, kx, vx, log_gamma[0], sc_f)
    ox_b, _ = retention_chunk_scan(flip(qx), flip(kx), flip(vx), log_gamma[1], sc_b)

    def finish(o, h):
        b, n, _ = h.shape
        o = rms_norm(o).astype(h.dtype).reshape(b, n, RET_HEADS * RET_VAL_DIM)
        return (jax.nn.silu(h @ w_g) * o) @ w_o

    yx = finish(ox_f + flip(ox_b), hx)
    yc = finish(oc_f + flip(oc_b), hc) if need_ctx else None
    return yx, yc


def setup_inputs(seed: int = 0) -> dict:
    key = jax.random.key(seed)
    keys = iter(jax.random.split(key, 40))

    def nrm(shape, std=1.0):
        return jax.random.normal(next(keys), shape, jnp.float32) * std

    d = D_MODEL
    n_a, n_b, n_c = [len(range(kind, DEPTH, N_MIXERS)) for kind in range(N_MIXERS)]
    gamma = 1.0 - 2.0 ** (-5.0 - np.arange(RET_HEADS))
    decay0 = jnp.asarray(np.log(-np.log(gamma)), jnp.float32)
    ret_qk = RET_HEADS * RET_KEY_DIM
    ret_v = RET_HEADS * RET_VAL_DIM
    return {
        'x': nrm((BATCH, SEQ, d)),
        'c': nrm((BATCH, d)),
        'ctx': nrm((BATCH, CTX_LEN, d)),
        'c_ctx': nrm((d,)),
        'ada_w': nrm((DEPTH, d, N_MOD * d), 0.5 * d ** -0.5),
        'ada_b': nrm((DEPTH, N_MOD * d), 0.01),
        'norm_mix_g': 1.0 + nrm((DEPTH, d), 0.02),
        'norm_ffn_g': 1.0 + nrm((DEPTH, d), 0.02),
        'ffn_w_gate_up': nrm((DEPTH, d, 2 * FFN_HIDDEN), d ** -0.5),
        'ffn_w_down': nrm((DEPTH, FFN_HIDDEN, d), FFN_HIDDEN ** -0.5),
        'da_w_qkv': nrm((n_a, d, 3 * DA_WIDTH), d ** -0.5),
        'da_w_o': nrm((n_a, DA_WIDTH, d), DA_WIDTH ** -0.5),
        'da_lambda': nrm((n_a, 4, DA_HEAD_DIM), 0.1),
        'da_subln_g': 1.0 + nrm((n_a, 2 * DA_HEAD_DIM), 0.02),
        'sg_w_in': nrm((n_b, d, 2 * SG_WIDTH), d ** -0.5),
        'sg_v_g': 1.0 + nrm((n_b, SG_WIDTH), 0.02),
        'sg_w_s': nrm((n_b, SG_GROUPS, SG_CHUNK, SG_CHUNK), SG_CHUNK ** -0.5),
        'sg_b_s': 1.0 + nrm((n_b, SG_GROUPS, SG_CHUNK), 0.02),
        'sg_w_out': nrm((n_b, SG_WIDTH, d), SG_WIDTH ** -0.5),
        'ret_w_q': nrm((n_c, d, ret_qk), d ** -0.5),
        'ret_w_k': nrm((n_c, d, ret_qk), d ** -0.5),
        'ret_w_v': nrm((n_c, d, ret_v), d ** -0.5),
        'ret_w_g': nrm((n_c, d, ret_v), d ** -0.5),
        'ret_w_o': nrm((n_c, ret_v, d), ret_v ** -0.5),
        'ret_decay': decay0 + nrm((n_c, 2, RET_HEADS), 0.05),
        'final_norm_g': 1.0 + nrm((d,), 0.02),
    }


def reference(x, c, ctx, c_ctx, ada_w, ada_b, norm_mix_g, norm_ffn_g, ffn_w_gate_up, ffn_w_down,
              da_w_qkv, da_w_o, da_lambda, da_subln_g,
              sg_w_in, sg_v_g, sg_w_s, sg_b_s, sg_w_out,
              ret_w_q, ret_w_k, ret_w_v, ret_w_g, ret_w_o, ret_decay, final_norm_g):
    n_lat = x.shape[1]
    da_cos, da_sin = axial_rope_tables(n_lat, DA_HEAD_DIM, x.dtype)
    ret_cos, ret_sin = axial_rope_tables(n_lat, RET_KEY_DIM, x.dtype)
    silu_c = jax.nn.silu(c)
    silu_cc = jax.nn.silu(c_ctx)

    for i in range(DEPTH):
        last = i == DEPTH - 1
        kind = i % N_MIXERS
        j = i // N_MIXERS
        mod_x = (silu_c @ ada_w[i] + ada_b[i])[:, None, :]
        mod_c = silu_cc @ ada_w[i] + ada_b[i]
        sx1, cx1, gx1, sx2, cx2, gx2 = jnp.split(mod_x, N_MOD, axis=-1)
        sc1, cc1, gc1, sc2, cc2, gc2 = jnp.split(mod_c, N_MOD, axis=-1)

        hx = modulate(rms_norm(x, norm_mix_g[i]), sx1, cx1)
        hc = modulate(rms_norm(ctx, norm_mix_g[i]), sc1, cc1)
        if kind == 0:
            lambda_init = 0.8 - 0.6 * math.exp(-0.3 * i)
            yx, yc = diff_attention_mixer(hx, hc, da_w_qkv[j], da_w_o[j], da_lambda[j], da_subln_g[j],
                                          lambda_init, da_cos, da_sin, not last)
        elif kind == 1:
            yx = spatial_gating_mixer(hx, sg_w_in[j], sg_v_g[j], sg_w_s[j], sg_b_s[j], sg_w_out[j])
            yc = None if last else spatial_gating_mixer(hc, sg_w_in[j], sg_v_g[j], sg_w_s[j], sg_b_s[j], sg_w_out[j])
        else:
            yx, yc = retention_mixer(hx, hc, ret_w_q[j], ret_w_k[j], ret_w_v[j], ret_w_g[j], ret_w_o[j],
                                     ret_decay[j], ret_cos, ret_sin, not last)

        x = x + gx1 * yx
        x = x + gx2 * swiglu(modulate(rms_norm(x, norm_ffn_g[i]), sx2, cx2), ffn_w_gate_up[i], ffn_w_down[i])
        if not last:
            ctx = ctx + gc1 * yc
            ctx = ctx + gc2 * swiglu(modulate(rms_norm(ctx, norm_ffn_g[i]), sc2, cc2),
                                     ffn_w_gate_up[i], ffn_w_down[i])

    return rms_norm(x, final_norm_g)
```

```cpp
#include <hip/hip_runtime.h>
#include <cstdio>
#include <cstdint>

constexpr int DM = 2048, NB = 2, SEQ = 4096, CTXL = 256, TB = SEQ + CTXL  , MALL = NB * TB  ;
constexpr int FFH = 5632, DEPTH = 4;
constexpr float EPSN = 1e-6f;

namespace pg8 {
#define PG8_LAS __attribute__((address_space(3)))
typedef unsigned short bf16_t;
typedef short bf16x8 __attribute__((ext_vector_type(8)));
typedef float f32x4 __attribute__((ext_vector_type(4)));
typedef unsigned u32x4 __attribute__((ext_vector_type(4)));
constexpr int BM = 256, BK = 64, HALF = 128, HTB = HALF * BK * 2  , STAGE_BYTES = 8 * HTB, NXCD = 8, WGM = 8;

__host__ __device__ __forceinline__ int lds_byte(int r, int c) { const int st = (r >> 4) * 2 + (c >> 5), rr = r & 15, cc = c & 31, ob = rr * 64 + cc * 2; return st * 1024 + (ob ^ (((ob >> 9) & 1) << 5)); }
__host__ __device__ __forceinline__ void stage_rc(int b, int& R, int& C) { const int st = b / 1024, sb = b % 1024, swz = sb ^ (((sb >> 9) & 1) << 5); R = (st >> 1) * 16 + swz / 64; C = (st & 1) * 32 + (swz % 64) / 2; }
__host__ __device__ __forceinline__ int perm32(int rho) { const int n = rho >> 4, i = rho & 15; return 8 * (i >> 2) + 4 * n + (i & 3); }

struct Unit { int pm, pn; };
struct Gemm { const bf16_t* A; const bf16_t* Bt; int M, N, K; };


struct Order {
    int nM, nN, nwg, G, c, skip;
    __device__ __forceinline__ void init(int nM_, int nN_, int G_, int c_, int skip_) { nM = nM_; nN = nN_; nwg = nM * nN; G = G_; c = c_; skip = skip_; }
    __device__ __forceinline__ bool next(int i, Unit& u) const {
        const long L = (long)i * G + c; if (L >= nwg) return false;
        int wgid = (int)L; { const int q = nwg / NXCD, r = nwg % NXCD, xcd = wgid % NXCD, off = wgid / NXCD; wgid = (xcd < r ? xcd * (q + 1) : r * (q + 1) + (xcd - r) * q) + off; }
        const int nig = WGM * nN, gid = wgid / nig, fm = gid * WGM, gsz = (nM - fm) < WGM ? (nM - fm) : WGM;
        int pm = fm + ((wgid % nig) % gsz); u.pn = (wgid % nig) / gsz;
        if (skip) pm = pm + 1 + (pm >= 16 ? 1 : 0);
        u.pm = pm; return true;
    }
    __device__ __forceinline__ void a_ready(const Unit&) const {}
    __device__ __forceinline__ void done(const Unit&) const {}
};

__device__ __forceinline__ unsigned cvt_pk_bf16(float lo, float hi) { unsigned r; asm volatile("v_cvt_pk_bf16_f32 %0, %1, %2" : "=v"(r) : "v"(lo), "v"(hi)); return r; }
typedef float f32x2 __attribute__((ext_vector_type(2)));
__device__ __forceinline__ f32x2 gelu_pk(f32x2 v) {
    const f32x2 av = __builtin_elementwise_abs(v), d = av * 0.2316418882f + 1.0f;
    f32x2 t; t.x = __builtin_amdgcn_rcpf(d.x); t.y = __builtin_amdgcn_rcpf(d.y);
    f32x2 q = t * 0.5307027145f + (-0.7265760135f); q = q * t + 0.7107068705f; q = q * t + (-0.142248368f); q = q * t + 0.127414796f; q = q * t;
    const f32x2 s = (v * v) * (-0.72134752044f);
    f32x2 e; e.x = __builtin_amdgcn_exp2f(s.x); e.y = __builtin_amdgcn_exp2f(s.y);
    const f32x2 m = v * (q * e), r = v - m;
    f32x2 o; o.x = v.x < 0.f ? m.x : r.x; o.y = v.y < 0.f ? m.y : r.y; return o;
}
__device__ __forceinline__ f32x4 gelu4(f32x4 v) { const f32x2 a = gelu_pk((f32x2){v[0], v[1]}), b = gelu_pk((f32x2){v[2], v[3]}); return (f32x4){a.x, a.y, b.x, b.y}; }
__device__ __forceinline__ float silu1(float x) { return x * __builtin_amdgcn_rcpf(1.0f + __builtin_amdgcn_exp2f(-1.4426950408889634f * x)); }
__device__ __forceinline__ f32x4 silu4(f32x4 v) { return (f32x4){silu1(v[0]), silu1(v[1]), silu1(v[2]), silu1(v[3])}; }
__device__ __forceinline__ u32x4 pack8(f32x4 a, f32x4 b) { u32x4 w; w.x = cvt_pk_bf16(a[0], a[1]); w.y = cvt_pk_bf16(a[2], a[3]); w.z = cvt_pk_bf16(b[0], b[1]); w.w = cvt_pk_bf16(b[2], b[3]); return w; }
__device__ __forceinline__ int cvec_of_panel(int pm) { return (pm % 17 == 0) ? 2 : pm / 17; }

struct EpiRes {
    static constexpr bool PERM = false, AFTER_DRAIN = false;
    float* X; const float* modl; int gofs;
    __device__ __forceinline__ void operator()(const f32x4 (&acc)[2][2][4][2], const Unit& u, int wr, int wc, int fr, int fq) const {
        const float* gate = modl + cvec_of_panel(u.pm) * 12288 + gofs;
        const int row0 = u.pm * BM + wr * 64 + fr, col0 = u.pn * BM + wc * 32 + 4 * fq;
        f32x4 gv[2][2];
#pragma unroll
        for (int bj = 0; bj < 2; ++bj)
#pragma unroll
            for (int n = 0; n < 2; ++n) gv[bj][n] = *(const f32x4*)(gate + col0 + bj * HALF + n * 16);
#pragma unroll
        for (int ai = 0; ai < 2; ++ai)
#pragma unroll
            for (int m = 0; m < 4; ++m) { float* rowp = X + (size_t)(row0 + ai * HALF + m * 16) * DM + col0;
#pragma unroll
                for (int bj = 0; bj < 2; ++bj)
#pragma unroll
                    for (int n = 0; n < 2; ++n) { f32x4* p = (f32x4*)(rowp + bj * HALF + n * 16); *p = *p + gv[bj][n] * acc[ai][bj][m][n]; } }
    }
};
struct EpiSwiglu {
    static constexpr bool PERM = true, AFTER_DRAIN = false;
    bf16_t* H;
    __device__ __forceinline__ void operator()(const f32x4 (&acc)[2][2][4][2], const Unit& u, int wr, int wc, int fr, int fq) const {
        const int row0 = u.pm * BM + wr * 64 + fr, col0 = u.pn * HALF + wc * 32 + 8 * fq;
#pragma unroll
        for (int ai = 0; ai < 2; ++ai)
#pragma unroll
            for (int m = 0; m < 4; ++m) { bf16_t* rowp = H + (size_t)(row0 + ai * HALF + m * 16) * FFH + col0;
                const f32x4 o0 = silu4(acc[ai][0][m][0]) * acc[ai][1][m][0], o1 = silu4(acc[ai][0][m][1]) * acc[ai][1][m][1];
                *(u32x4*)rowp = pack8(o0, o1); }
    }
};
struct EpiQkvDa {
    static constexpr bool PERM = true, AFTER_DRAIN = false;
    bf16_t *Q, *K, *V; const float *rc, *rs;
    __device__ __forceinline__ void operator()(const f32x4 (&acc)[2][2][4][2], const Unit& u, int wr, int wc, int fr, int fq) const {
        const int row0 = u.pm * BM + wr * 64 + fr;
        if (u.pn >= 16) {
            const int col0 = (u.pn - 16) * BM + wc * 32 + 8 * fq;
#pragma unroll
            for (int ai = 0; ai < 2; ++ai)
#pragma unroll
                for (int m = 0; m < 4; ++m) { bf16_t* rowp = V + (size_t)(row0 + ai * HALF + m * 16) * DM + col0;
#pragma unroll
                    for (int bj = 0; bj < 2; ++bj) *(u32x4*)(rowp + bj * HALF) = pack8(acc[ai][bj][m][0], acc[ai][bj][m][1]); }
        } else {
            bf16_t* dst = (u.pn < 8) ? Q : K; const int h = u.pn & 7;
            const bool lat = (u.pm % 17) != 0; const int tb = (u.pm / 17) * TB + CTXL;
            const int mp = wc >> 1, dd0 = (wc & 1) * 32 + 8 * fq, colb = h * 256 + mp * 128 + dd0;
#pragma unroll
            for (int ai = 0; ai < 2; ++ai)
#pragma unroll
                for (int m = 0; m < 4; ++m) { const int row = row0 + ai * HALF + m * 16;
                    f32x4 o1a = acc[ai][0][m][0], o1b = acc[ai][0][m][1], o2a = acc[ai][1][m][0], o2b = acc[ai][1][m][1];
                    if (lat) { const size_t to = (size_t)(row - tb) * 64 + dd0;
                        const f32x4 ca = *(const f32x4*)(rc + to), cb = *(const f32x4*)(rc + to + 4), sa = *(const f32x4*)(rs + to), sb = *(const f32x4*)(rs + to + 4);
                        const f32x4 x1a = o1a, x1b = o1b, x2a = o2a, x2b = o2b;
                        o1a = x1a * ca - x2a * sa; o2a = x1a * sa + x2a * ca; o1b = x1b * cb - x2b * sb; o2b = x1b * sb + x2b * cb; }
                    bf16_t* rowp = dst + (size_t)row * DM + colb;
                    *(u32x4*)rowp = pack8(o1a, o1b); *(u32x4*)(rowp + 64) = pack8(o2a, o2b); }
        }
    }
};
struct EpiSgIn {
    static constexpr bool PERM = true, AFTER_DRAIN = false;
    bf16_t *U, *V; float* VSS;
    __device__ __forceinline__ void operator()(const f32x4 (&acc)[2][2][4][2], const Unit& u, int wr, int wc, int fr, int fq) const {
        const int row0 = u.pm * BM + wr * 64 + fr; const bool isv = u.pn >= 8;
        bf16_t* dst = isv ? V : U; const int col0 = (u.pn & 7) * BM + wc * 32 + 8 * fq;
#pragma unroll
        for (int ai = 0; ai < 2; ++ai)
#pragma unroll
            for (int m = 0; m < 4; ++m) { const int row = row0 + ai * HALF + m * 16; bf16_t* rowp = dst + (size_t)row * DM + col0; float ss = 0.f;
#pragma unroll
                for (int bj = 0; bj < 2; ++bj) { const f32x4 v0 = gelu4(acc[ai][bj][m][0]), v1 = gelu4(acc[ai][bj][m][1]);
                    ss += (v0[0] * v0[0] + v0[1] * v0[1]) + (v0[2] * v0[2] + v0[3] * v0[3]) + (v1[0] * v1[0] + v1[1] * v1[1]) + (v1[2] * v1[2] + v1[3] * v1[3]);
                    *(u32x4*)(rowp + bj * HALF) = pack8(v0, v1); }
                if (isv) { ss += __shfl_xor(ss, 16); ss += __shfl_xor(ss, 32); if (fq == 0) VSS[(size_t)row * 32 + (u.pn - 8) * 4 + wc] = ss; } }
    }
};
struct EpiRet {
    static constexpr bool PERM = true, AFTER_DRAIN = false;
    bf16_t *Q, *K, *V, *Gt; const float *rc, *rs;
    __device__ __forceinline__ void operator()(const f32x4 (&acc)[2][2][4][2], const Unit& u, int wr, int wc, int fr, int fq) const {
        const int row0 = u.pm * BM + wr * 64 + fr;
        if (u.pn >= 16) {
            const bool isg = u.pn >= 32; bf16_t* dst = isg ? Gt : V; const int col0 = ((u.pn - 16) & 15) * BM + wc * 32 + 8 * fq;
#pragma unroll
            for (int ai = 0; ai < 2; ++ai)
#pragma unroll
                for (int m = 0; m < 4; ++m) { bf16_t* rowp = dst + (size_t)(row0 + ai * HALF + m * 16) * 4096 + col0;
#pragma unroll
                    for (int bj = 0; bj < 2; ++bj) { f32x4 v0 = acc[ai][bj][m][0], v1 = acc[ai][bj][m][1]; if (isg) { v0 = silu4(v0); v1 = silu4(v1); }
                        *(u32x4*)(rowp + bj * HALF) = pack8(v0, v1); } }
        } else {
            const bool isk = u.pn >= 8; bf16_t* dst = isk ? K : Q; const int h = u.pn & 7; const float sc = isk ? 0.0625f : 1.0f;
            const bool lat = (u.pm % 17) != 0; const int tb = (u.pm / 17) * TB + CTXL;
            const int p0 = wc * 32 + 8 * fq, colb = h * 256 + p0;
#pragma unroll
            for (int ai = 0; ai < 2; ++ai)
#pragma unroll
                for (int m = 0; m < 4; ++m) { const int row = row0 + ai * HALF + m * 16;
                    f32x4 o1a = acc[ai][0][m][0], o1b = acc[ai][0][m][1], o2a = acc[ai][1][m][0], o2b = acc[ai][1][m][1];
                    if (lat) { const size_t to = (size_t)(row - tb) * 128 + p0;
                        const f32x4 ca = *(const f32x4*)(rc + to), cb = *(const f32x4*)(rc + to + 4), sa = *(const f32x4*)(rs + to), sb = *(const f32x4*)(rs + to + 4);
                        const f32x4 x1a = o1a, x1b = o1b, x2a = o2a, x2b = o2b;
                        o1a = x1a * ca - x2a * sa; o2a = x1a * sa + x2a * ca; o1b = x1b * cb - x2b * sb; o2b = x1b * sb + x2b * cb; }
                    bf16_t* rowp = dst + (size_t)row * DM + colb;
                    *(u32x4*)rowp = pack8(o1a * sc, o1b * sc); *(u32x4*)(rowp + 128) = pack8(o2a * sc, o2b * sc); }
        }
    }
};

template <class Epi, class Sched, bool ALIGN_EPI = false, bool SP2 = false>
__device__ __forceinline__ void gemm_phase(const int tid, PG8_LAS unsigned char* lds, const Gemm g, const Sched& S, const Epi& E) {
    const int wid = __builtin_amdgcn_readfirstlane(tid >> 6), lane = tid & 63, wr = wid >> 2, wc = wid & 3, fr = lane & 15, fq = lane >> 4;
    const int K = g.K, nt = K / BK;
    unsigned voffA[2], voffB[2];
#pragma unroll
    for (int i = 0; i < 2; ++i) { int R, C; stage_rc(tid * 16 + i * 8192, R, C); const int Rb = Epi::PERM ? ((R & ~31) + perm32(R & 31)) : R;
        voffA[i] = (unsigned)(R * K + C) * 2u; voffB[i] = (unsigned)(Rb * K + C) * 2u; }
    const size_t kstep = (size_t)(BK * 2);
    const size_t hstep = (size_t)HALF * K * 2;
    const size_t tstep = 2 * hstep;
    const unsigned ldsw = (unsigned)wid * 1024u;
    const int aoff = lds_byte(wr * 64 + fr, fq * 8), boff = lds_byte(wc * 32 + fr, fq * 8);
#define PG8_SA(b, h) (((b) * 2 + (h)) * HTB)
#define PG8_SB(b, h) ((4 + (b) * 2 + (h)) * HTB)
#define PG8_STAGE(bufoff, gbase, voff) do { _Pragma("unroll") for (int _i = 0; _i < 2; ++_i) \
        __builtin_amdgcn_global_load_lds((const unsigned*)((const char*)(gbase) + (voff)[_i]), (PG8_LAS unsigned*)(lds + (bufoff) + ldsw + _i * 8192), 16, 0, 0); } while (0)
#define PG8_LDA(dst, b, h) do { _Pragma("unroll") for (int m = 0; m < 4; ++m) _Pragma("unroll") for (int k = 0; k < 2; ++k) dst[m][k] = *(const PG8_LAS bf16x8*)(lds + PG8_SA(b, h) + aoff + m * 2048 + k * 1024); } while (0)
#define PG8_LDB(dst, b, h) do { _Pragma("unroll") for (int n = 0; n < 2; ++n) _Pragma("unroll") for (int k = 0; k < 2; ++k) dst[n][k] = *(const PG8_LAS bf16x8*)(lds + PG8_SB(b, h) + boff + n * 2048 + k * 1024); } while (0)
#define PG8_MMA(ai, bj, At, Bt) do { __builtin_amdgcn_s_setprio(1); _Pragma("unroll") for (int m = 0; m < 4; ++m) _Pragma("unroll") for (int n = 0; n < 2; ++n) _Pragma("unroll") for (int k = 0; k < 2; ++k) \
        acc[ai][bj][m][n] = __builtin_amdgcn_mfma_f32_16x16x32_bf16(Bt[n][k], At[m][k], acc[ai][bj][m][n], 0, 0, 0); __builtin_amdgcn_s_setprio(0); } while (0)
#define PG8_WAIT_V(n) asm volatile("s_waitcnt vmcnt(" #n ")" ::: "memory")
#define PG8_WAIT_L(n) asm volatile("s_waitcnt lgkmcnt(" #n ")" ::: "memory")
#define PG8_BAR __builtin_amdgcn_s_barrier()
#define PG8_SCHED __builtin_amdgcn_sched_barrier(0)
    Unit cur, nxt; int ui = 0;
    if (!S.next(0, cur)) return;
    f32x4 acc[2][2][4][2];
#pragma unroll
    for (int a = 0; a < 2; ++a)
#pragma unroll
        for (int b = 0; b < 2; ++b)
#pragma unroll
            for (int m = 0; m < 4; ++m)
#pragma unroll
                for (int n = 0; n < 2; ++n) acc[a][b][m][n] = (f32x4){0.f, 0.f, 0.f, 0.f};
    bf16x8 At[4][2], B0[2][2], B1[2][2];
    const char* cA = (const char*)g.A + (size_t)cur.pm * tstep; const char* cB = (const char*)g.Bt + (size_t)cur.pn * tstep;
    S.a_ready(cur);
    if constexpr (SP2) {
        PG8_STAGE(PG8_SB(0, 0), cB, voffB); PG8_STAGE(PG8_SB(0, 1), cB + hstep, voffB); PG8_STAGE(PG8_SA(0, 0), cA, voffA); PG8_STAGE(PG8_SA(0, 1), cA + hstep, voffA);
        if (wr == 1) PG8_BAR;
        PG8_WAIT_V(2); PG8_BAR;
        PG8_STAGE(PG8_SB(1, 0), cB + kstep, voffB); PG8_STAGE(PG8_SA(1, 0), cA + kstep, voffA); PG8_STAGE(PG8_SB(1, 1), cB + hstep + kstep, voffB);
        PG8_WAIT_V(6); PG8_BAR;
    } else {
        PG8_STAGE(PG8_SB(0, 0), cB, voffB); PG8_STAGE(PG8_SA(0, 0), cA, voffA); PG8_STAGE(PG8_SB(0, 1), cB + hstep, voffB); PG8_STAGE(PG8_SA(0, 1), cA + hstep, voffA);
        if (wr == 1) PG8_BAR;
        PG8_WAIT_V(4); PG8_BAR;
        PG8_STAGE(PG8_SB(1, 0), cB + kstep, voffB); PG8_STAGE(PG8_SA(1, 0), cA + kstep, voffA); PG8_STAGE(PG8_SB(1, 1), cB + hstep + kstep, voffB);
        PG8_WAIT_V(6); PG8_BAR;
    }
    for (;;) {
        const bool has_next = S.next(ui + 1, nxt);
        const char* nA = has_next ? (const char*)g.A + (size_t)nxt.pm * tstep : cA; const char* nB = has_next ? (const char*)g.Bt + (size_t)nxt.pn * tstep : cB;
        for (int t = 0; t < nt; t += 2) {
            const bool last = (t == nt - 2);
            const char* a1 = cA + (size_t)(t + 1) * kstep;
            const char* a2 = last ? nA : cA + (size_t)(t + 2) * kstep; const char* b2 = last ? nB : cB + (size_t)(t + 2) * kstep;
            const char* a3 = a2 + kstep; const char* b3 = b2 + kstep;
            if (last && has_next) S.a_ready(nxt);
            if constexpr (SP2) {
            PG8_LDB(B0, 0, 0); PG8_LDB(B1, 0, 1); PG8_SCHED; PG8_LDA(At, 0, 0); PG8_STAGE(PG8_SA(1, 1), a1 + hstep, voffA);
            PG8_WAIT_V(8); PG8_WAIT_L(0); PG8_BAR; PG8_MMA(0, 0, At, B0); PG8_MMA(0, 1, At, B1); PG8_BAR; PG8_SCHED;
            PG8_LDA(At, 0, 1); PG8_STAGE(PG8_SB(0, 0), b2, voffB); PG8_STAGE(PG8_SB(0, 1), b2 + hstep, voffB); PG8_STAGE(PG8_SA(0, 0), a2, voffA);
            PG8_WAIT_V(8); PG8_WAIT_L(0); PG8_BAR; PG8_MMA(1, 0, At, B0); PG8_MMA(1, 1, At, B1); PG8_BAR; PG8_SCHED;
            PG8_LDB(B0, 1, 0); PG8_LDB(B1, 1, 1); PG8_SCHED; PG8_LDA(At, 1, 0); PG8_STAGE(PG8_SA(0, 1), a2 + hstep, voffA);
            PG8_WAIT_V(8); PG8_WAIT_L(0); PG8_BAR; PG8_MMA(0, 0, At, B0); PG8_MMA(0, 1, At, B1); PG8_BAR; PG8_SCHED;
            PG8_LDA(At, 1, 1); PG8_STAGE(PG8_SB(1, 0), b3, voffB); PG8_STAGE(PG8_SB(1, 1), b3 + hstep, voffB); PG8_STAGE(PG8_SA(1, 0), a3, voffA);
            PG8_WAIT_V(8); PG8_WAIT_L(0); PG8_BAR; PG8_MMA(1, 0, At, B0); PG8_MMA(1, 1, At, B1); PG8_BAR; PG8_SCHED;
            } else {
            PG8_LDB(B0, 0, 0); PG8_SCHED; PG8_LDA(At, 0, 0); PG8_STAGE(PG8_SA(1, 1), a1 + hstep, voffA);
            PG8_WAIT_L(8); PG8_BAR; PG8_WAIT_L(0); PG8_MMA(0, 0, At, B0); PG8_BAR; PG8_SCHED;
            PG8_LDB(B1, 0, 1); PG8_STAGE(PG8_SB(0, 0), b2, voffB);
            PG8_BAR; PG8_WAIT_L(0); PG8_MMA(0, 1, At, B1); PG8_BAR;
            PG8_LDA(At, 0, 1); PG8_STAGE(PG8_SA(0, 0), a2, voffA);
            PG8_BAR; PG8_WAIT_L(0); PG8_MMA(1, 0, At, B0); PG8_BAR; PG8_SCHED;
            PG8_STAGE(PG8_SB(0, 1), b2 + hstep, voffB);
            PG8_WAIT_V(6); PG8_BAR; PG8_MMA(1, 1, At, B1); PG8_BAR;
            PG8_LDB(B0, 1, 0); PG8_SCHED; PG8_LDA(At, 1, 0); PG8_STAGE(PG8_SA(0, 1), a2 + hstep, voffA);
            PG8_WAIT_L(8); PG8_BAR; PG8_WAIT_L(0); PG8_MMA(0, 0, At, B0); PG8_BAR; PG8_SCHED;
            PG8_LDB(B1, 1, 1); PG8_STAGE(PG8_SB(1, 0), b3, voffB);
            PG8_BAR; PG8_WAIT_L(0); PG8_MMA(0, 1, At, B1); PG8_BAR;
            PG8_LDA(At, 1, 1); PG8_STAGE(PG8_SA(1, 0), a3, voffA);
            PG8_BAR; PG8_WAIT_L(0); PG8_MMA(1, 0, At, B0); PG8_BAR; PG8_SCHED;
            PG8_STAGE(PG8_SB(1, 1), b3 + hstep, voffB);
            PG8_WAIT_V(6); PG8_BAR; PG8_MMA(1, 1, At, B1); PG8_BAR;
            }
        }
        if constexpr (ALIGN_EPI) { if (wr == 0) PG8_BAR; }
        if constexpr (!Epi::AFTER_DRAIN) { E(acc, cur, wr, wc, fr, fq); S.done(cur); }
        if (!has_next) break;
#pragma unroll
        for (int a = 0; a < 2; ++a)
#pragma unroll
            for (int b = 0; b < 2; ++b)
#pragma unroll
                for (int m = 0; m < 4; ++m)
#pragma unroll
                    for (int n = 0; n < 2; ++n) acc[a][b][m][n] = (f32x4){0.f, 0.f, 0.f, 0.f};
        cur = nxt; cA = nA; cB = nB; ++ui;
        if constexpr (ALIGN_EPI) { if (wr == 1) PG8_BAR; }
    }
    PG8_WAIT_V(0);
    if constexpr (!ALIGN_EPI) { if (wr == 0) PG8_BAR; }
    PG8_BAR;
    if constexpr (Epi::AFTER_DRAIN) { E.fused(acc, cur, wr, wc, fr, fq, lds, wid, lane); S.done(cur); }
#undef PG8_SA
#undef PG8_SB
#undef PG8_STAGE
#undef PG8_LDA
#undef PG8_LDB
#undef PG8_MMA
#undef PG8_WAIT_V
#undef PG8_WAIT_L
#undef PG8_BAR
#undef PG8_SCHED
}
}
namespace att {
typedef unsigned short bf16;
constexpr int   D = 128, NW = 8, QBLK = 32, KVBLK = 64;
constexpr float SCALE = 0.088388347648318440f;
constexpr float THR = 8.f;
#ifndef ATT_SDEPTH
#define ATT_SDEPTH 1
#endif
constexpr int SDEPTH = ATT_SDEPTH;
constexpr size_t SHM_V = KVBLK * D * 2, SHM_K = KVBLK * D * 2, SHM_ATTN = 2 * SHM_V + 2 * SHM_K + NW * 64 * 4;
using bf16x8 = __attribute__((ext_vector_type(8))) short;
using s16x4  = __attribute__((ext_vector_type(4))) short;
using f32x16 = __attribute__((ext_vector_type(16))) float;
using f32x8  = __attribute__((ext_vector_type(8))) float;
using u32x4  = __attribute__((ext_vector_type(4))) unsigned;
#define KSWZ(row, colB) ((row) * 256 + ((colB) ^ (((row) & 7) << 4)))
#define SBAR() __builtin_amdgcn_sched_barrier(0)
__device__ __forceinline__ int crow(int r, int hi) { return (r & 3) + 8 * (r >> 2) + 4 * hi; }
__device__ __forceinline__ unsigned cvtpk(float lo, float hi) {
  unsigned r; asm volatile("v_cvt_pk_bf16_f32 %0, %1, %2" : "=v"(r) : "v"(lo), "v"(hi)); return r;
}
__device__ __forceinline__ void partialSM(f32x16& p0, f32x16& p1, float& m_reg, float& mn, float& alpha) {
  constexpr float C = SCALE * 1.4426950408889634f;
  float pmax = p0[0]; for (int r = 1; r < 16; ++r) pmax = fmaxf(pmax, p0[r]); for (int r = 0; r < 16; ++r) pmax = fmaxf(pmax, p1[r]);
  { auto rr = __builtin_amdgcn_permlane32_swap(__float_as_uint(pmax), __float_as_uint(pmax), false, false);
    pmax = fmaxf(__uint_as_float(rr[0]), __uint_as_float(rr[1])); }
  if (__builtin_expect(__all(pmax - m_reg <= THR / SCALE), 1)) { mn = m_reg; alpha = 1.f; }
  else { mn = fmaxf(m_reg, pmax); alpha = __builtin_amdgcn_exp2f((m_reg - mn) * C); m_reg = mn; }
  float mnC = -mn * C;
  for (int r = 0; r < 16; ++r) p0[r] = fmaf(p0[r], C, mnC); for (int r = 0; r < 16; ++r) p1[r] = fmaf(p1[r], C, mnC);
  for (int r = 0; r < 16; ++r) p0[r] = __builtin_amdgcn_exp2f(p0[r]);
}
__device__ __forceinline__ void finishSM(f32x16& p0, f32x16& p1, float alpha, float& l_reg, bf16x8& pa0, bf16x8& pa1, bf16x8& pa2, bf16x8& pa3) {
  for (int r = 0; r < 16; ++r) p1[r] = __builtin_amdgcn_exp2f(p1[r]);
  float ps = 0; for (int r = 0; r < 16; ++r) ps += p0[r]; for (int r = 0; r < 16; ++r) ps += p1[r];
  { auto rr = __builtin_amdgcn_permlane32_swap(__float_as_uint(ps), __float_as_uint(ps), false, false);
    ps = __uint_as_float(rr[0]) + __uint_as_float(rr[1]); }
  l_reg = l_reg * alpha + ps;
#define PK4(P, BASE, OUT) do { unsigned a0 = cvtpk(P[BASE + 0], P[BASE + 1]), a1 = cvtpk(P[BASE + 2], P[BASE + 3]);   \
    unsigned b0 = cvtpk(P[BASE + 4], P[BASE + 5]), b1 = cvtpk(P[BASE + 6], P[BASE + 7]);                              \
    auto r0 = __builtin_amdgcn_permlane32_swap(a0, b0, false, false); auto r1 = __builtin_amdgcn_permlane32_swap(a1, b1, false, false); \
    u32x4 w = {r0[0], r1[0], r0[1], r1[1]}; OUT = *reinterpret_cast<bf16x8*>(&w); } while (0)
  PK4(p0, 0, pa0); PK4(p0, 8, pa1); PK4(p1, 0, pa2); PK4(p1, 8, pa3);
#undef PK4
}
__device__ __forceinline__ void qkt(f32x16& p0, f32x16& p1, const bf16* Ks, const bf16x8* qr, int r32, int hi) {
  p0 = f32x16{}; p1 = f32x16{};
  for (int d0 = 0; d0 < 8; ++d0) { int cb = (d0 * 16 + hi * 8) * 2;
    bf16x8 b0 = *reinterpret_cast<const bf16x8*>((const char*)Ks + KSWZ(r32, cb));
    bf16x8 b1 = *reinterpret_cast<const bf16x8*>((const char*)Ks + KSWZ(32 + r32, cb));
    p0 = __builtin_amdgcn_mfma_f32_32x32x16_bf16(b0, qr[d0], p0, 0, 0, 0);
    p1 = __builtin_amdgcn_mfma_f32_32x32x16_bf16(b1, qr[d0], p1, 0, 0, 0); }
}
__device__ __forceinline__ int v_st(int k, int c) { const int kk = (k & ~0xC) | ((k & 4) << 1) | ((k & 8) >> 1); return ((kk >> 3) * 4 + (c >> 5)) * 512 + ((kk & 7) * 32 + (c & 31)) * 2; }
__device__ __forceinline__ int v_rd_base(int lane) { return ((lane & 3) << 3) | (((lane >> 2) & 3) << 6) | (((lane >> 4) & 1) << 5) | (((lane >> 5) & 1) << 8); }
constexpr int v_rd_off(int d0, int ks, int half) { return d0 * 512 + ks * 4096 + half * 2048; }
template <int OFF> __device__ __forceinline__ s16x4 tr_read(int vb) {
  s16x4 r; asm volatile("ds_read_b64_tr_b16 %0, %1 offset:%2" : "=&v"(r) : "v"(vb), "i"(OFF) : "memory"); return r;
}
template <int D0> __device__ __forceinline__ void pv_one(f32x16& od, int vb, bf16x8 pa0, bf16x8 pa1, bf16x8 pa2, bf16x8 pa3) {
  const s16x4 l0 = tr_read<v_rd_off(D0, 0, 0)>(vb), h0 = tr_read<v_rd_off(D0, 0, 1)>(vb), l1 = tr_read<v_rd_off(D0, 1, 0)>(vb), h1 = tr_read<v_rd_off(D0, 1, 1)>(vb);
  const s16x4 l2 = tr_read<v_rd_off(D0, 2, 0)>(vb), h2 = tr_read<v_rd_off(D0, 2, 1)>(vb), l3 = tr_read<v_rd_off(D0, 3, 0)>(vb), h3 = tr_read<v_rd_off(D0, 3, 1)>(vb);
  asm volatile("s_waitcnt lgkmcnt(0)" ::: "memory"); SBAR();
#define PK(L, H) (bf16x8){L[0], L[1], L[2], L[3], H[0], H[1], H[2], H[3]}
  od = __builtin_amdgcn_mfma_f32_32x32x16_bf16(pa0, PK(l0, h0), od, 0, 0, 0);
  od = __builtin_amdgcn_mfma_f32_32x32x16_bf16(pa1, PK(l1, h1), od, 0, 0, 0);
  od = __builtin_amdgcn_mfma_f32_32x32x16_bf16(pa2, PK(l2, h2), od, 0, 0, 0);
  od = __builtin_amdgcn_mfma_f32_32x32x16_bf16(pa3, PK(l3, h3), od, 0, 0, 0);
#undef PK
}
__device__ __forceinline__ void pv_d0(f32x16* o, int vb, bf16x8 pa0, bf16x8 pa1, bf16x8 pa2, bf16x8 pa3) {
  pv_one<0>(o[0], vb, pa0, pa1, pa2, pa3); pv_one<1>(o[1], vb, pa0, pa1, pa2, pa3); pv_one<2>(o[2], vb, pa0, pa1, pa2, pa3); pv_one<3>(o[3], vb, pa0, pa1, pa2, pa3);
}

template <int LDQ, int LDK, int LDO>
__device__ __forceinline__ void attn_dense_body(const int tid, const bf16* __restrict__ Qb, const bf16* __restrict__ Kh, const bf16* __restrict__ Vh,
                                                float* __restrict__ Ob, int seq, char* lds) {

  const int wid = tid >> 6, lane = tid & 63, r32 = lane & 31, hi = lane >> 5;
  bf16* V_lds = (bf16*)lds; bf16* K_lds = (bf16*)(lds + 2 * SHM_V);
  float* ws = (float*)(lds + 2 * SHM_V + 2 * SHM_K) + wid * 64; float* li_l = ws; float* al_l = ws + 32;
  float m_reg = -1e30f, l_reg = 0; f32x16 o[4] = {}; bf16x8 qr[8];
  const bf16* Qw = Qb + (long)(wid * QBLK + r32) * LDQ + hi * 8;
#pragma unroll
  for (int d0 = 0; d0 < 8; ++d0) qr[d0] = *reinterpret_cast<const bf16x8*>(Qw + d0 * 16);
  const int sr = tid >> 4, sc = (tid & 15) * 8, vst0 = v_st(sr, sc), vst1 = v_st(32 + sr, sc);
  const int vb0 = (int)(uintptr_t)V_lds + v_rd_base(lane);
  struct { bf16x8 vs0, vs1, ks0, ks1; } sr_[SDEPTH];
#define SLOAD(i, k0) do { sr_[i].vs0 = (*reinterpret_cast<const bf16x8*>(&Vh[(long)((k0) + sr) * LDK + sc])); sr_[i].vs1 = (*reinterpret_cast<const bf16x8*>(&Vh[(long)((k0) + 32 + sr) * LDK + sc])); \
    sr_[i].ks0 = (*reinterpret_cast<const bf16x8*>(&Kh[(long)((k0) + sr) * LDK + sc])); sr_[i].ks1 = (*reinterpret_cast<const bf16x8*>(&Kh[(long)((k0) + 32 + sr) * LDK + sc])); } while (0)
#define SWRITE(b, i) do { *(bf16x8*)((char*)V_lds + (b) * SHM_V + vst0) = sr_[i].vs0;          \
    *(bf16x8*)((char*)V_lds + (b) * SHM_V + vst1) = sr_[i].vs1; int kc = sc * 2;               \
    *(bf16x8*)((char*)K_lds + (b) * SHM_K + KSWZ(sr, kc)) = sr_[i].ks0;                       \
    *(bf16x8*)((char*)K_lds + (b) * SHM_K + KSWZ(32 + sr, kc)) = sr_[i].ks1; } while (0)
#define SWAIT() do { if constexpr (SDEPTH == 2) asm volatile("s_waitcnt vmcnt(4)" ::: "memory"); else asm volatile("s_waitcnt vmcnt(0)" ::: "memory"); } while (0)
#define RESC(a) do { if (__any((a) < 1.f)) { if (hi == 0) al_l[r32] = (a); asm volatile("s_waitcnt lgkmcnt(0)" ::: "memory"); \
    for (int d = 0; d < 4; ++d) for (int r = 0; r < 16; ++r) o[d][r] *= al_l[crow(r, hi)]; } } while (0)
  f32x16 pA0, pA1, pB0, pB1; float mnA, mnB, alA, alB; bf16x8 pa0, pa1, pa2, pa3; const int NT = seq / KVBLK;
  constexpr int SE = 0, SO = SDEPTH - 1;
  SLOAD(SE, 0); asm volatile("s_waitcnt vmcnt(0)" ::: "memory"); SWRITE(0, SE); __syncthreads();
  qkt(pA0, pA1, K_lds, qr, r32, hi); partialSM(pA0, pA1, m_reg, mnA, alA);
  SLOAD(SO, KVBLK); if constexpr (SDEPTH == 2) { if (2 < NT) SLOAD(SE, 2 * KVBLK); }
  SWAIT(); SWRITE(1, SO); __syncthreads();
  for (int j = 1; j + 1 < NT; j += 2) {
    SBAR(); qkt(pB0, pB1, (bf16*)((char*)K_lds + SHM_K), qr, r32, hi);
    finishSM(pA0, pA1, alA, l_reg, pa0, pa1, pa2, pa3); SBAR();
    SLOAD(SO, (j + SDEPTH) * KVBLK); SBAR();
    pv_d0(o, vb0, pa0, pa1, pa2, pa3); partialSM(pB0, pB1, m_reg, mnB, alB);
    __syncthreads(); SWAIT(); SWRITE(0, SE);
    RESC(alB); __syncthreads();
    SBAR(); qkt(pA0, pA1, K_lds, qr, r32, hi);
    finishSM(pB0, pB1, alB, l_reg, pa0, pa1, pa2, pa3); SBAR();
    if (SDEPTH == 1 || j + 3 < NT) SLOAD(SE, (j + 1 + SDEPTH) * KVBLK); SBAR();
    pv_d0(o, vb0 + (int)SHM_V, pa0, pa1, pa2, pa3); partialSM(pA0, pA1, m_reg, mnA, alA);
    __syncthreads(); SWAIT(); SWRITE(1, SO);
    RESC(alA); __syncthreads();
  }
  SBAR(); qkt(pB0, pB1, (bf16*)((char*)K_lds + SHM_K), qr, r32, hi);
  finishSM(pA0, pA1, alA, l_reg, pa0, pa1, pa2, pa3); SBAR();
  pv_d0(o, vb0, pa0, pa1, pa2, pa3); partialSM(pB0, pB1, m_reg, mnB, alB);
  __syncthreads(); RESC(alB);
  finishSM(pB0, pB1, alB, l_reg, pa0, pa1, pa2, pa3); SBAR();
  pv_d0(o, vb0 + (int)SHM_V, pa0, pa1, pa2, pa3);
  if (hi == 0) li_l[r32] = l_reg; asm volatile("s_waitcnt lgkmcnt(0)" ::: "memory");
  float rli[16];
#pragma unroll
  for (int r = 0; r < 16; ++r) rli[r] = __builtin_amdgcn_rcpf(li_l[crow(r, hi)]);
  float* Ow = Ob + (long)(wid * QBLK) * LDO;
#pragma unroll
  for (int r = 0; r < 16; ++r) { int orow = crow(r, hi);
    for (int d0 = 0; d0 < 4; ++d0) Ow[(long)orow * LDO + d0 * 32 + r32] = o[d0][r] * rli[r]; }
#undef SLOAD
#undef SWRITE
#undef SWAIT
#undef RESC
}
}
#define GAS __attribute__((address_space(1)))
#define LAS __attribute__((address_space(3)))
typedef unsigned short bf16;
typedef unsigned v4u __attribute__((ext_vector_type(4)));
typedef unsigned v2u __attribute__((ext_vector_type(2)));
typedef float f32x4 __attribute__((ext_vector_type(4)));
typedef short bf16x8 __attribute__((ext_vector_type(8)));
typedef GAS unsigned gu32;
#define RLX_AGENT __ATOMIC_RELAXED, __HIP_MEMORY_SCOPE_AGENT
#define LDS_WAIT() asm volatile("s_waitcnt lgkmcnt(0)" ::: "memory")
#define VM_WAIT() asm volatile("s_waitcnt vmcnt(0)" ::: "memory")
__device__ __forceinline__ unsigned f2bf(float f) { unsigned u = __builtin_bit_cast(unsigned, f); return (u + 0x7fffu + ((u >> 16) & 1u)) >> 16; }
__device__ __forceinline__ unsigned pk2(float lo, float hi) { return f2bf(lo) | (f2bf(hi) << 16); }
__device__ __forceinline__ float bf_lo(unsigned w) { return __builtin_bit_cast(float, w << 16); }
__device__ __forceinline__ float bf_hi(unsigned w) { return __builtin_bit_cast(float, w & 0xffff0000u); }
__device__ __forceinline__ float wave_sum(float v) {
#pragma unroll
    for (int o = 1; o < 64; o <<= 1) v += __shfl_xor(v, o);
    return v;
}
__device__ __forceinline__ f32x4 mfma16(bf16x8 a, bf16x8 b, f32x4 c) { return __builtin_amdgcn_mfma_f32_16x16x32_bf16(a, b, c, 0, 0, 0); }

__device__ __forceinline__ const float* in_ptr(const LAS unsigned long long* TBL, int i) {
    const unsigned long long v = TBL[i]; const unsigned lo = __builtin_amdgcn_readfirstlane((unsigned)v), hi = __builtin_amdgcn_readfirstlane((unsigned)(v >> 32));
    return (const float*)(const GAS float*)(uintptr_t)(((unsigned long long)hi << 32) | lo);
}
#define INP(i) in_ptr(TBL, i)

#define XB_TMO      128
#define XB_XCNT(j)  (256  + 64 * (j))
#define XB_XSUB(j)  (1280 + 64 * (j))
#define XB_XGEN(j)  (2304 + 64 * (j))
#define XB_TOP      3328
#define XB_TOPGEN   3392
#define XCD_BAR_WORDS 3456
#define XB_SPIN_CAP (1u << 18)

__device__ __forceinline__ unsigned xb_ld(unsigned* p)              { return __hip_atomic_load(p, __ATOMIC_RELAXED, __HIP_MEMORY_SCOPE_AGENT); }
__device__ __forceinline__ unsigned xb_add(unsigned* p, unsigned v) { return __hip_atomic_fetch_add(p, v, __ATOMIC_RELAXED, __HIP_MEMORY_SCOPE_AGENT); }
__device__ __forceinline__ unsigned xb_xcc_id() { return (unsigned)__builtin_amdgcn_s_getreg((3 << 11) | 20) & 0xFu; }
#define XB_SPIN(cond, bar) do { unsigned _sp = 0; while (cond) { __builtin_amdgcn_s_sleep(1); \
    if ((++_sp & 255u) == 0u) { if (xb_ld(&(bar)[XB_TMO])) break; if (_sp > XB_SPIN_CAP) { atomicAdd(&(bar)[XB_TMO], 1u); break; } } } } while (0)

struct XcdBarrier {
    unsigned* bar; unsigned x;
    volatile LAS unsigned* st;
};

__device__ __forceinline__ XcdBarrier xcd_barrier_post(unsigned* bar, volatile LAS unsigned* st) {
    XcdBarrier b; b.bar = bar; b.x = xb_xcc_id(); b.st = st;
    if (threadIdx.x == 0) (void)xb_add(&bar[XB_XCNT(b.x)], 1u);
    return b;
}
__device__ __forceinline__ void xcd_barrier_complete(unsigned* bar, unsigned x, unsigned& nloc, unsigned& nx) {
    const unsigned G = gridDim.x * gridDim.y * gridDim.z;
    unsigned sum, cnt, mine, sp = 0u;
    for (;;) {
        sum = 0u; cnt = 0u; mine = 0u;
#pragma unroll
        for (unsigned j = 0; j < 16; ++j) { const unsigned c = xb_ld(&bar[XB_XCNT(j)]); sum += c; cnt += (c > 0u) ? 1u : 0u; mine = (j == x) ? c : mine; }
        if (sum == G) break;
        __builtin_amdgcn_s_sleep(1);
        if ((++sp & 255u) == 0u) { if (xb_ld(&bar[XB_TMO])) break; if (sp > XB_SPIN_CAP) { atomicAdd(&bar[XB_TMO], 1u); break; } }
    }
    nloc = mine > 0u ? mine : 1u; nx = cnt > 0u ? cnt : 1u;
}

__device__ __forceinline__ void xcd_barrier(const XcdBarrier& b) {
    asm volatile("s_waitcnt vmcnt(0)" ::: "memory");
    __syncthreads();
    if (threadIdx.x == 0) {
        unsigned* bar = b.bar;
        __builtin_amdgcn_s_waitcnt(0);
        unsigned nloc = b.st[0], nx = b.st[1];
        if (nloc == 0u) { xcd_barrier_complete(bar, b.x, nloc, nx); b.st[0] = nloc; b.st[1] = nx; }
        const unsigned old = xb_add(&bar[XB_XSUB(b.x)], 1u);
        const unsigned gen = old / nloc;
        if (old + 1u == (gen + 1u) * nloc) {
            __builtin_amdgcn_fence(__ATOMIC_RELEASE, "agent");
            asm volatile("s_waitcnt vmcnt(0)" ::: "memory");
            const unsigned og = xb_add(&bar[XB_TOP], 1u);
            const unsigned tg = og / nx;
            if (og + 1u == (tg + 1u) * nx) xb_add(&bar[XB_TOPGEN], 1u);
            else XB_SPIN(xb_ld(&bar[XB_TOPGEN]) == tg, bar);
            __builtin_amdgcn_fence(__ATOMIC_ACQUIRE, "agent");
            xb_add(&bar[XB_XGEN(b.x)], 1u);
            asm volatile("s_waitcnt vmcnt(0)" ::: "memory");
        } else {
            XB_SPIN(xb_ld(&bar[XB_XGEN(b.x)]) == gen, bar);
            __builtin_amdgcn_fence(__ATOMIC_ACQUIRE, "agent");
            asm volatile("s_waitcnt vmcnt(0)" ::: "memory");
        }
    }
    __syncthreads();
}
constexpr size_t MiB = 1u << 20;
constexpr size_t WS_CTL = 0, CTL_ZERO_BYTES = 1 * MiB;
constexpr size_t WS_MODP = 1 * MiB;
constexpr size_t WS_MOD = 6 * MiB;
constexpr size_t WS_RCDA = 7 * MiB, WS_RSDA = 8 * MiB;
constexpr size_t WS_RCRT = 9 * MiB, WS_RSRT = 11 * MiB;
constexpr size_t WS_VSS = 13 * MiB;
constexpr size_t WS_WQKV = 16 * MiB;
constexpr size_t WS_WODA = 64 * MiB;
constexpr size_t WS_WSGI = 80 * MiB, WS_WSGO = 96 * MiB;
constexpr size_t WS_WRET = 104 * MiB, WS_WRETO = 152 * MiB;
constexpr size_t WS_WGU = 168 * MiB;
constexpr size_t WS_WD = 344 * MiB;
constexpr size_t WS_X = 432 * MiB;
constexpr size_t WS_HN = 500 * MiB;
constexpr size_t WS_HID = 534 * MiB;
constexpr size_t WS_ACT = 628 * MiB;
constexpr size_t WS_END = 1172 * MiB;
constexpr size_t A34 = 34 * MiB;
constexpr int CW_BAR = 4096;

constexpr int LDS_BYTES = 147456, MISC_OFF = 139264;

struct Args { const float* in[26]; float* out; unsigned char* ws; int ph_lo, ph_hi; };
enum { I_X = 0, I_C, I_CTX, I_CCTX, I_ADAW, I_ADAB, I_NMG, I_NFG, I_WGU, I_WD, I_DAQKV, I_DAO, I_DALAM, I_DASUB, I_SGIN, I_SGVG, I_SGWS, I_SGBS, I_SGOUT,
       I_RQ, I_RK, I_RV, I_RG, I_RO, I_RDEC, I_FNG };

struct TJob { const float* W; bf16* WT; int K, N, kind, row_off; };
__device__ __forceinline__ int dest_row(int kind, int n0) {
    if (kind == 1) {
        if (n0 >= 4096) return n0;
        const int sec = n0 >> 11, r = n0 & 2047, h = r >> 8, m = (r >> 7) & 1, hf = (r >> 6) & 1;
        return sec * 2048 + h * 256 + hf * 128 + m * 64;
    }
    if (kind == 2) {
        if (n0 < FFH) return (n0 >> 7) * 256 + (n0 & 127);
        const int n1 = n0 - FFH; return (n1 >> 7) * 256 + 128 + (n1 & 127);
    }
    return n0;
}
__device__ __forceinline__ void transpose_item(const TJob& J, int item, LAS bf16* scr, int lane) {
    const int nblk = J.N >> 6, kb = item / nblk, nb = item - kb * nblk, k0 = kb << 6, n0 = nb << 6;
    const int drow = J.row_off + dest_row(J.kind, n0);
    const float* src = J.W + (size_t)(k0 + (lane >> 4)) * J.N + n0 + 4 * (lane & 15);
    f32x4 v[16];
#pragma unroll
    for (int i = 0; i < 16; ++i) v[i] = *(const f32x4*)(src + (size_t)(4 * i) * J.N);
#pragma unroll
    for (int i = 0; i < 16; ++i) { const int kk = (lane >> 4) + 4 * i; LAS unsigned* d = (LAS unsigned*)(scr + kk * 66 + 4 * (lane & 15));
        d[0] = pg8::cvt_pk_bf16(v[i].x, v[i].y); d[1] = pg8::cvt_pk_bf16(v[i].z, v[i].w); }
    LDS_WAIT();
    const int c = lane & 7;
#pragma unroll
    for (int j = 0; j < 8; ++j) { const int n = (lane >> 3) + 8 * j; const LAS bf16* s = scr + (8 * c) * 66 + n;
        v4u o; o.x = (unsigned)s[0] | ((unsigned)s[66] << 16); o.y = (unsigned)s[132] | ((unsigned)s[198] << 16);
        o.z = (unsigned)s[264] | ((unsigned)s[330] << 16); o.w = (unsigned)s[396] | ((unsigned)s[462] << 16);
        *(v4u*)(J.WT + (size_t)(drow + n) * J.K + k0 + 8 * c) = o; }
    LDS_WAIT();
}
__device__ __forceinline__ void gemv_item(const float* ada_w, float* MODP, const LAS float* SC, int it, int lane) {
    const int l = it / 384, rem = it - l * 384, ks = rem / 48, nc = rem - ks * 48;
    const float* Wp = ada_w + ((size_t)l * 2048 + ks * 256) * 12288 + nc * 256 + 4 * lane;
    f32x4 a0 = {0.f, 0.f, 0.f, 0.f}, a1 = a0, a2 = a0;
    for (int k = 0; k < 256; k += 16) {
        f32x4 w[16];
#pragma unroll
        for (int i = 0; i < 16; ++i) w[i] = *(const f32x4*)(Wp + (size_t)(k + i) * 12288);
#pragma unroll
        for (int i = 0; i < 16; ++i) { const int kk = ks * 256 + k + i; const float s0 = SC[kk], s1 = SC[2048 + kk], s2 = SC[4096 + kk];
            a0 += w[i] * s0; a1 += w[i] * s1; a2 += w[i] * s2; }
    }
    float* o = MODP + ((size_t)(ks * 4 + l) * 3) * 12288 + nc * 256 + 4 * lane;
    *(f32x4*)o = a0; *(f32x4*)(o + 12288) = a1; *(f32x4*)(o + 24576) = a2;
}

__device__ __forceinline__ void prologue_phase(const LAS unsigned long long* TBL, unsigned char* ws, LAS unsigned char* lds, int tid, int lane, int wave, int gw, int NGW) {
    LAS float* SC = (LAS float*)(lds + 69632);
    for (int idx = tid; idx < 3 * 2048; idx += 512) { const float cv = (idx < 4096) ? INP(I_C)[idx] : INP(I_CCTX)[idx - 4096]; SC[idx] = cv / (1.0f + __expf(-cv)); }
    __syncthreads();
    LAS bf16* scr = (LAS bf16*)(lds + wave * 8448);
    constexpr int N_GEMV = 4 * 8 * 48, N_T = 53248, N_XC = MALL, N_ROPE = SEQ, N_ALL = N_GEMV + N_T + N_XC + N_ROPE;
    for (int it = gw; it < N_ALL; it += NGW) {
        if (it < N_GEMV) { gemv_item(INP(I_ADAW), (float*)(ws + WS_MODP), SC, it, lane); continue; }
        int r = it - N_GEMV;
        if (r < N_T) {
            TJob J; bool found = false;
#define TJ(src_, dst_, K_, N_, kind_, ro_) { const int n_ = ((K_) >> 6) * ((N_) >> 6); if (!found) { if (r < n_) { J.W = (src_); J.WT = (bf16*)(dst_); J.K = (K_); J.N = (N_); J.kind = (kind_); J.row_off = (ro_); found = true; } else r -= n_; } }
            TJ(INP(I_WGU), ws + WS_WGU, 2048, 11264, 2, 0)
            TJ(INP(I_WGU) + (size_t)1 * 2048 * 11264, ws + WS_WGU + 44 * MiB, 2048, 11264, 2, 0)
            TJ(INP(I_WGU) + (size_t)2 * 2048 * 11264, ws + WS_WGU + 88 * MiB, 2048, 11264, 2, 0)
            TJ(INP(I_WGU) + (size_t)3 * 2048 * 11264, ws + WS_WGU + 132 * MiB, 2048, 11264, 2, 0)
            TJ(INP(I_WD), ws + WS_WD, 5632, 2048, 0, 0)
            TJ(INP(I_WD) + (size_t)1 * 5632 * 2048, ws + WS_WD + 22 * MiB, 5632, 2048, 0, 0)
            TJ(INP(I_WD) + (size_t)2 * 5632 * 2048, ws + WS_WD + 44 * MiB, 5632, 2048, 0, 0)
            TJ(INP(I_WD) + (size_t)3 * 5632 * 2048, ws + WS_WD + 66 * MiB, 5632, 2048, 0, 0)
            TJ(INP(I_DAQKV), ws + WS_WQKV, 2048, 6144, 1, 0)
            TJ(INP(I_DAQKV) + (size_t)2048 * 6144, ws + WS_WQKV + 24 * MiB, 2048, 6144, 1, 0)
            TJ(INP(I_DAO), ws + WS_WODA, 2048, 2048, 0, 0)
            TJ(INP(I_DAO) + (size_t)2048 * 2048, ws + WS_WODA + 8 * MiB, 2048, 2048, 0, 0)
            TJ(INP(I_SGIN), ws + WS_WSGI, 2048, 4096, 0, 0)
            TJ(INP(I_SGOUT), ws + WS_WSGO, 2048, 2048, 0, 0)
            TJ(INP(I_RQ), ws + WS_WRET, 2048, 2048, 0, 0)
            TJ(INP(I_RK), ws + WS_WRET, 2048, 2048, 0, 2048)
            TJ(INP(I_RV), ws + WS_WRET, 2048, 4096, 0, 4096)
            TJ(INP(I_RG), ws + WS_WRET, 2048, 4096, 0, 8192)
            TJ(INP(I_RO), ws + WS_WRETO, 4096, 2048, 0, 0)
#undef TJ
            if (found) transpose_item(J, r, scr, lane);
            continue;
        }
        r -= N_T;
        if (r < N_XC) {
            const int b = r / TB, i = r - b * TB;
            const float* src = (i < CTXL) ? INP(I_CTX) + (size_t)(b * CTXL + i) * DM : INP(I_X) + (size_t)(b * SEQ + i - CTXL) * DM;
            float* dst = (float*)(ws + WS_X) + (size_t)r * DM;
#pragma unroll
            for (int j = 0; j < 8; ++j) *(f32x4*)(dst + 256 * j + 4 * lane) = *(const f32x4*)(src + 256 * j + 4 * lane);
            continue;
        }
        r -= N_XC;
        {
            const float rowp = (float)(r >> 6), colp = (float)(r & 63);
            { const int f = lane & 31; const float inv = __builtin_amdgcn_exp2f(-(float)f * (13.287712379549449f / 32.0f)); const float ang = ((lane < 32) ? rowp : colp) * inv;
              const float rev = ang * 0.15915494309189535f, fr = rev - floorf(rev);
              ((float*)(ws + WS_RCDA))[(size_t)r * 64 + lane] = __builtin_amdgcn_cosf(fr); ((float*)(ws + WS_RSDA))[(size_t)r * 64 + lane] = __builtin_amdgcn_sinf(fr); }
#pragma unroll
            for (int q = 0; q < 2; ++q) { const int j = lane + 64 * q, f = j & 63; const float inv = __builtin_amdgcn_exp2f(-(float)f * (13.287712379549449f / 64.0f)); const float ang = ((j < 64) ? rowp : colp) * inv;
              const float rev = ang * 0.15915494309189535f, fr = rev - floorf(rev);
              ((float*)(ws + WS_RCRT))[(size_t)r * 128 + j] = __builtin_amdgcn_cosf(fr); ((float*)(ws + WS_RSRT))[(size_t)r * 128 + j] = __builtin_amdgcn_sinf(fr); }
        }
    }
    __syncthreads();
}
__device__ __forceinline__ void modreduce_phase(const LAS unsigned long long* TBL, unsigned char* ws, int gtid, int gthreads) {
    const float* MODP = (const float*)(ws + WS_MODP); float* MOD = (float*)(ws + WS_MOD);
    for (int idx = gtid; idx < 36864; idx += gthreads) {
        const int e = idx * 4, l = e / 36864, rem = e - l * 36864, j = rem / 12288, n = rem - j * 12288;
        f32x4 s = *(const f32x4*)(INP(I_ADAB) + l * 12288 + n);
#pragma unroll
        for (int ks = 0; ks < 8; ++ks) s += *(const f32x4*)(MODP + ((size_t)(ks * 4 + l) * 3 + j) * 12288 + n);
        *(f32x4*)(MOD + e) = s;
    }
}
__device__ __forceinline__ void norm_phase(LAS unsigned char* lds, int tid, int lane, int gw, int NGW, const float* X, bf16* HN, const float* gain, const float* modl, int sofs, int cofs, bool skipctx) {
    LAS float* A = (LAS float*)lds; LAS float* Bv = A + 3 * 2048;
    for (int idx = tid; idx < 3 * 2048; idx += 512) { const int j = idx >> 11, c = idx & 2047; A[idx] = gain[c] * (1.0f + modl[j * 12288 + cofs + c]); Bv[idx] = modl[j * 12288 + sofs + c]; }
    __syncthreads();
    for (int r = gw; r < MALL; r += NGW) {
        const int b = r / TB, i = r - b * TB, jv = (i < CTXL) ? 2 : b;
        if (skipctx && jv == 2) continue;
        const float* xr = X + (size_t)r * DM + 4 * lane;
        f32x4 v[8]; float ss = 0.f;
#pragma unroll
        for (int j = 0; j < 8; ++j) { v[j] = *(const f32x4*)(xr + 256 * j); ss += (v[j].x * v[j].x + v[j].y * v[j].y) + (v[j].z * v[j].z + v[j].w * v[j].w); }
        ss = wave_sum(ss); const float rstd = 1.0f / sqrtf(ss * (1.0f / 2048.0f) + EPSN);
        const LAS float* Aj = A + jv * 2048 + 4 * lane; const LAS float* Bj = Bv + jv * 2048 + 4 * lane;
        bf16* hr = HN + (size_t)r * DM + 4 * lane;
#pragma unroll
        for (int j = 0; j < 8; ++j) { const f32x4 aa = *(const LAS f32x4*)(Aj + 256 * j), bb = *(const LAS f32x4*)(Bj + 256 * j); const f32x4 h = v[j] * rstd * aa + bb;
            v2u o; o.x = pg8::cvt_pk_bf16(h.x, h.y); o.y = pg8::cvt_pk_bf16(h.z, h.w); *(v2u*)(hr + 256 * j) = o; }
    }
    __syncthreads();
}
__device__ __forceinline__ void final_norm_phase(int lane, int gw, int NGW, const float* X, float* out, const float* gain) {
    for (int r = gw; r < NB * SEQ; r += NGW) {
        const int b = r / SEQ, t = r - b * SEQ; const float* xr = X + (size_t)(b * TB + CTXL + t) * DM + 4 * lane;
        f32x4 v[8]; float ss = 0.f;
#pragma unroll
        for (int j = 0; j < 8; ++j) { v[j] = *(const f32x4*)(xr + 256 * j); ss += (v[j].x * v[j].x + v[j].y * v[j].y) + (v[j].z * v[j].z + v[j].w * v[j].w); }
        ss = wave_sum(ss); const float rstd = 1.0f / sqrtf(ss * (1.0f / 2048.0f) + EPSN);
        float* orow = out + (size_t)r * DM + 4 * lane;
#pragma unroll
        for (int j = 0; j < 8; ++j) *(f32x4*)(orow + 256 * j) = v[j] * rstd * *(const f32x4*)(gain + 256 * j + 4 * lane);
    }
}
__device__ __forceinline__ void da_attn_phase(char* ldsg, int tid, int vcu, int G, const bf16* Q, const bf16* K, const bf16* V, float* OF, bool need_ctx) {
    const int nlat = 1024, total = nlat + (need_ctx ? 64 : 0);
#pragma unroll 1
    for (int u = vcu; u < total; u += G) {
        int head, qb; if (u < nlat) { head = u >> 4; qb = 1 + (u & 15); } else { head = u - nlat; qb = 0; }
        const int b = head >> 5, h = (head >> 2) & 7, m = (head >> 1) & 1, vh = head & 1;
        const size_t rb = (size_t)b * TB;
        const bf16* Qb = Q + (rb + (size_t)qb * 256) * DM + h * 256 + m * 128;
        const bf16* Kh = K + rb * DM + h * 256 + m * 128;
        const bf16* Vh = V + rb * DM + h * 256 + vh * 128;
        float* Ob = OF + (rb + (size_t)qb * 256) * 4096 + (h * 2 + m) * 256 + vh * 128;
        att::attn_dense_body<DM, DM, 4096>(tid, Qb, Kh, Vh, Ob, qb == 0 ? CTXL : TB, ldsg);
        __syncthreads();
    }
}
__device__ __forceinline__ void da_combine_phase(int lane, int gw, int NGW, const float* OF, bf16* DAO, const float* lamv, const float* subg, float lambda_init, bool need_ctx) {
    float sa = lamv[lane] * lamv[128 + lane] + lamv[64 + lane] * lamv[192 + lane], sb = lamv[256 + lane] * lamv[384 + lane] + lamv[320 + lane] * lamv[448 + lane];
    sa = wave_sum(sa); sb = wave_sum(sb);
    const float lam = expf(sa) - expf(sb) + lambda_init, post = 1.0f - lambda_init;
    const f32x4 g4 = *(const f32x4*)(subg + 4 * lane) * post;
    for (int r = gw; r < MALL; r += NGW) {
        const int i = r % TB; if (!need_ctx && i < CTXL) continue;
        const float* orow = OF + (size_t)r * 4096 + 4 * lane; bf16* drow = DAO + (size_t)r * DM + 4 * lane;
#pragma unroll
        for (int h = 0; h < 8; ++h) {
            const f32x4 o1 = *(const f32x4*)(orow + h * 512), o2 = *(const f32x4*)(orow + h * 512 + 256); const f32x4 o = o1 - o2 * lam;
            float ss = (o.x * o.x + o.y * o.y) + (o.z * o.z + o.w * o.w); ss = wave_sum(ss);
            const float rstd = 1.0f / sqrtf(ss * (1.0f / 256.0f) + EPSN); const f32x4 y = o * rstd * g4;
            v2u w; w.x = pg8::cvt_pk_bf16(y.x, y.y); w.y = pg8::cvt_pk_bf16(y.z, y.w); *(v2u*)(drow + h * 256) = w;
        }
    }
}
__device__ __forceinline__ void sg_phase(LAS unsigned char* lds, int tid, int lane, int wave, int vcu, int G, const bf16* U, const bf16* V, const float* VSS,
                                         const float* w_s, const float* b_s, const float* v_gain, bf16* Gout) {
    LAS bf16* vL = (LAS bf16*)lds;
    LAS bf16* wL = (LAS bf16*)(lds + 33280);
    LAS float* rs = (LAS float*)(lds + 68096);
    const int l15 = lane & 15, l4 = lane >> 4;
    for (int unit = vcu; unit < 68 * 16; unit += G) {
        const int ci = unit >> 4, g = unit & 15, row0 = ci * 128;
        __syncthreads();
        if (tid < 128) { const float* p = VSS + (size_t)(row0 + tid) * 32; float s = 0.f;
#pragma unroll
            for (int k = 0; k < 32; ++k) s += p[k];
            rs[tid] = 1.0f / sqrtf(s * (1.0f / 2048.0f) + EPSN); }
        { const int q = tid >> 2, c0 = (tid & 3) * 32; const v4u* src = (const v4u*)(V + (size_t)(row0 + q) * DM + g * 128 + c0); LAS unsigned* d = (LAS unsigned*)(vL + q * 130 + c0);
#pragma unroll
          for (int k = 0; k < 4; ++k) { const v4u x = src[k]; d[4 * k] = x.x; d[4 * k + 1] = x.y; d[4 * k + 2] = x.z; d[4 * k + 3] = x.w; } }
        __syncthreads();
        { const int p = tid >> 2, q0 = (tid & 3) * 32; const float* src = w_s + ((size_t)g * 128 + p) * 128 + q0;
#pragma unroll
          for (int k = 0; k < 4; ++k) { const f32x4 a = *(const f32x4*)(src + 8 * k), b = *(const f32x4*)(src + 8 * k + 4); const LAS float* r8 = rs + q0 + 8 * k;
              const f32x4 ra = *(const LAS f32x4*)r8, rb = *(const LAS f32x4*)(r8 + 4);
              *(LAS v4u*)(wL + p * 136 + q0 + 8 * k) = pg8::pack8(a * ra, b * rb); } }
        __syncthreads();
        bf16x8 aF[4];
#pragma unroll
        for (int kk = 0; kk < 4; ++kk) { const LAS bf16* s = vL + (32 * kk + 8 * l4) * 130 + 16 * wave + l15;
#pragma unroll
            for (int jj = 0; jj < 8; ++jj) aF[kk][jj] = (short)s[jj * 130]; }
        f32x4 acc[8];
#pragma unroll
        for (int pt = 0; pt < 8; ++pt) { acc[pt] = (f32x4){0.f, 0.f, 0.f, 0.f};
#pragma unroll
            for (int kk = 0; kk < 4; ++kk) { const bf16x8 bF = *(const LAS bf16x8*)(wL + (16 * pt + l15) * 136 + 32 * kk + 8 * l4); acc[pt] = mfma16(aF[kk], bF, acc[pt]); } }
        const int col = g * 128 + 16 * wave + 4 * l4; const f32x4 gn = *(const f32x4*)(v_gain + col);
#pragma unroll
        for (int pt = 0; pt < 8; ++pt) { const int p = 16 * pt + l15; const float bs = b_s[g * 128 + p]; const size_t off = (size_t)(row0 + p) * DM + col;
            const v2u uu = *(const v2u*)(U + off); const f32x4 sv = gn * acc[pt] + bs;
            v2u o; o.x = pg8::cvt_pk_bf16(bf_lo(uu.x) * sv.x, bf_hi(uu.x) * sv.y); o.y = pg8::cvt_pk_bf16(bf_lo(uu.y) * sv.z, bf_hi(uu.y) * sv.w); *(v2u*)(Gout + off) = o; }
    }
    __syncthreads();
}
__device__ __forceinline__ void ret_intra_phase(LAS unsigned char* lds, int tid, int lane, int wave, int vcu, int G, const bf16* Q, const bf16* K, const bf16* V, float* OI, const float* decay) {
    LAS bf16* PL = (LAS bf16*)lds;
    LAS bf16* vL = (LAS bf16*)(lds + 34816);
    const int l15 = lane & 15, l4 = lane >> 4;
    for (int unit = vcu; unit < 68 * 8; unit += G) {
        const int bc = unit >> 3, h = unit & 7, row0 = bc * 128;
        const float lgf = -expf(decay[h]) * 1.4426950408889634f, lgb = -expf(decay[8 + h]) * 1.4426950408889634f;
        __syncthreads();
        { bf16x8 qF[8]; const bf16* qp = Q + (size_t)(row0 + 16 * wave + l15) * DM + h * 256 + 8 * l4;
#pragma unroll
          for (int kk = 0; kk < 8; ++kk) qF[kk] = *(const bf16x8*)(qp + 32 * kk);
          const int i = 16 * wave + l15;
#pragma unroll 2
          for (int jt = 0; jt < 8; ++jt) { const bf16* kp = K + (size_t)(row0 + 16 * jt + l15) * DM + h * 256 + 8 * l4; f32x4 acc = {0.f, 0.f, 0.f, 0.f};
#pragma unroll
              for (int kk = 0; kk < 8; ++kk) { const bf16x8 kF = *(const bf16x8*)(kp + 32 * kk); acc = mfma16(kF, qF[kk], acc); }
              float pv[4];
#pragma unroll
              for (int r = 0; r < 4; ++r) { const int j = 16 * jt + 4 * l4 + r; const int dd = i - j;
                  const float w = (dd > 0) ? __builtin_amdgcn_exp2f(lgf * (float)dd) : (dd < 0) ? __builtin_amdgcn_exp2f(lgb * (float)(-dd)) : 2.0f; pv[r] = acc[r] * w; }
              v2u o; o.x = pg8::cvt_pk_bf16(pv[0], pv[1]); o.y = pg8::cvt_pk_bf16(pv[2], pv[3]); *(LAS v2u*)(PL + i * 136 + 16 * jt + 4 * l4) = o; } }
        for (int ec = 0; ec < 4; ++ec) {
            __syncthreads();
            { const int q = tid >> 2, c0 = (tid & 3) * 32; const v4u* src = (const v4u*)(V + (size_t)(row0 + q) * 4096 + h * 512 + ec * 128 + c0); LAS unsigned* d = (LAS unsigned*)(vL + q * 130 + c0);
#pragma unroll
              for (int k = 0; k < 4; ++k) { const v4u x = src[k]; d[4 * k] = x.x; d[4 * k + 1] = x.y; d[4 * k + 2] = x.z; d[4 * k + 3] = x.w; } }
            __syncthreads();
            bf16x8 aF[4];
#pragma unroll
            for (int kk = 0; kk < 4; ++kk) { const LAS bf16* s = vL + (32 * kk + 8 * l4) * 130 + 16 * wave + l15;
#pragma unroll
                for (int jj = 0; jj < 8; ++jj) aF[kk][jj] = (short)s[jj * 130]; }
#pragma unroll
            for (int it = 0; it < 8; ++it) { f32x4 acc = {0.f, 0.f, 0.f, 0.f};
#pragma unroll
                for (int kk = 0; kk < 4; ++kk) { const bf16x8 bF = *(const LAS bf16x8*)(PL + (16 * it + l15) * 136 + 32 * kk + 8 * l4); acc = mfma16(aF[kk], bF, acc); }
                *(f32x4*)(OI + (size_t)(row0 + 16 * it + l15) * 4096 + h * 512 + ec * 128 + 16 * wave + 4 * l4) = acc; }
        }
    }
    __syncthreads();
}
__device__ __forceinline__ void ret_scan_phase(LAS unsigned char* lds, int tid, int lane, int wave, int vcu, int G, const bf16* Q, const bf16* K, const bf16* V, float* ORr, const float* decay) {
    LAS bf16* KL = (LAS bf16*)lds;
    LAS bf16* VL = (LAS bf16*)(lds + 67584);
    LAS bf16* SB = (LAS bf16*)(lds + 67584 + 8704);
    const int l15 = lane & 15, l4 = lane >> 4;
    for (int unit = vcu; unit < 256; unit += G) {
        const int b = unit >> 7, h = (unit >> 4) & 7, s = unit & 15;
#pragma unroll 1
        for (int dir = 0; dir < 2; ++dir) {
            const float lg2 = -expf(decay[dir * 8 + h]) * 1.4426950408889634f; const float gC = __builtin_amdgcn_exp2f(lg2 * 128.0f);
            f32x4 Sr[2][2];
#pragma unroll
            for (int a = 0; a < 2; ++a)
#pragma unroll
                for (int e = 0; e < 2; ++e) Sr[a][e] = (f32x4){0.f, 0.f, 0.f, 0.f};
#pragma unroll 1
            for (int step = 0; step < 34; ++step) {
                const int c = (dir == 0) ? step : (step < 2 ? 1 - step : 35 - step);
                const size_t row0 = (size_t)(b * 34 + c) * 128;
                __syncthreads();
#pragma unroll
                for (int a = 0; a < 2; ++a)
#pragma unroll
                    for (int e = 0; e < 2; ++e) { v2u o; o.x = pg8::cvt_pk_bf16(Sr[a][e][0], Sr[a][e][1]); o.y = pg8::cvt_pk_bf16(Sr[a][e][2], Sr[a][e][3]);
                        *(LAS v2u*)(SB + (16 * e + l15) * 264 + 16 * (2 * wave + a) + 4 * l4) = o; }
                { const int j = tid >> 2, c0 = (tid & 3) * 64; const v4u* src = (const v4u*)(K + (row0 + j) * DM + h * 256 + c0); LAS v4u* d = (LAS v4u*)(KL + j * 264 + c0);
#pragma unroll
                  for (int k = 0; k < 8; ++k) d[k] = src[k];
                  const float z = __builtin_amdgcn_exp2f(lg2 * (float)((dir == 0) ? (127 - j) : j));
                  const v4u x = *(const v4u*)(V + (row0 + j) * 4096 + h * 512 + s * 32 + (tid & 3) * 8); LAS unsigned* dv = (LAS unsigned*)(VL + j * 34 + (tid & 3) * 8);
                  dv[0] = pg8::cvt_pk_bf16(bf_lo(x.x) * z, bf_hi(x.x) * z); dv[1] = pg8::cvt_pk_bf16(bf_lo(x.y) * z, bf_hi(x.y) * z);
                  dv[2] = pg8::cvt_pk_bf16(bf_lo(x.z) * z, bf_hi(x.z) * z); dv[3] = pg8::cvt_pk_bf16(bf_lo(x.w) * z, bf_hi(x.w) * z); }
                __syncthreads();
                { bf16x8 qF[8]; const bf16* qp = Q + (row0 + 16 * wave + l15) * DM + h * 256 + 8 * l4;
#pragma unroll
                  for (int kk = 0; kk < 8; ++kk) qF[kk] = *(const bf16x8*)(qp + 32 * kk);
                  const int i = 16 * wave + l15; const float xi = __builtin_amdgcn_exp2f(lg2 * (float)((dir == 0) ? (i + 1) : (128 - i)));
#pragma unroll
                  for (int et = 0; et < 2; ++et) { f32x4 acc = {0.f, 0.f, 0.f, 0.f};
#pragma unroll
                      for (int kk = 0; kk < 8; ++kk) { const bf16x8 sF = *(const LAS bf16x8*)(SB + (16 * et + l15) * 264 + 32 * kk + 8 * l4); acc = mfma16(sF, qF[kk], acc); }
                      f32x4* op = (f32x4*)(ORr + (row0 + i) * 4096 + h * 512 + s * 32 + 16 * et + 4 * l4);
                      if (dir == 0) *op = acc * xi; else *op = *op + acc * xi; } }
#pragma unroll
                for (int a = 0; a < 2; ++a)
#pragma unroll
                    for (int e = 0; e < 2; ++e) Sr[a][e] = Sr[a][e] * gC;
#pragma unroll
                for (int kk = 0; kk < 4; ++kk) { bf16x8 kF[2], vF[2];
#pragma unroll
                    for (int a = 0; a < 2; ++a) { const LAS bf16* sp = KL + (32 * kk + 8 * l4) * 264 + 16 * (2 * wave + a) + l15;
#pragma unroll
                        for (int jj = 0; jj < 8; ++jj) kF[a][jj] = (short)sp[jj * 264]; }
#pragma unroll
                    for (int e = 0; e < 2; ++e) { const LAS bf16* sp = VL + (32 * kk + 8 * l4) * 34 + 16 * e + l15;
#pragma unroll
                        for (int jj = 0; jj < 8; ++jj) vF[e][jj] = (short)sp[jj * 34]; }
#pragma unroll
                    for (int a = 0; a < 2; ++a)
#pragma unroll
                        for (int e = 0; e < 2; ++e) Sr[a][e] = mfma16(kF[a], vF[e], Sr[a][e]); }
            }
        }
    }
    __syncthreads();
}
__device__ __forceinline__ void ret_gate_phase(int lane, int gw, int NGW, const float* OI, const float* ORr, const bf16* Gt, bf16* RO) {
    for (int r = gw; r < MALL; r += NGW) {
#pragma unroll
        for (int h = 0; h < 8; ++h) { const size_t off = (size_t)r * 4096 + h * 512 + 4 * lane;
            const f32x4 o0 = *(const f32x4*)(OI + off) + *(const f32x4*)(ORr + off), o1 = *(const f32x4*)(OI + off + 256) + *(const f32x4*)(ORr + off + 256);
            float ss = (o0.x * o0.x + o0.y * o0.y) + (o0.z * o0.z + o0.w * o0.w) + (o1.x * o1.x + o1.y * o1.y) + (o1.z * o1.z + o1.w * o1.w); ss = wave_sum(ss);
            const float rstd = 1.0f / sqrtf(ss * (1.0f / 512.0f) + EPSN);
            const v2u g0 = *(const v2u*)(Gt + off), g1 = *(const v2u*)(Gt + off + 256);
            v2u w0, w1; w0.x = pg8::cvt_pk_bf16(bf_lo(g0.x) * o0.x * rstd, bf_hi(g0.x) * o0.y * rstd); w0.y = pg8::cvt_pk_bf16(bf_lo(g0.y) * o0.z * rstd, bf_hi(g0.y) * o0.w * rstd);
            w1.x = pg8::cvt_pk_bf16(bf_lo(g1.x) * o1.x * rstd, bf_hi(g1.x) * o1.y * rstd); w1.y = pg8::cvt_pk_bf16(bf_lo(g1.y) * o1.z * rstd, bf_hi(g1.y) * o1.w * rstd);
            *(v2u*)(RO + off) = w0; *(v2u*)(RO + off + 256) = w1; }
    }
}
template <class Epi> __device__ __forceinline__ void run_gemm(int tid, LAS unsigned char* lds, int G, const bf16* A, const bf16* Bt, int N, int K, bool skipctx, const Epi& E) {
    pg8::Gemm g{A, Bt, MALL, N, K}; pg8::Order S; S.init(skipctx ? 32 : 34, N / 256, G, (int)blockIdx.x, skipctx ? 1 : 0);
    pg8::gemm_phase<Epi, pg8::Order, true, true>(tid, lds, g, S, E);
}
constexpr int N_PHASES = 2 + 8 * DEPTH + 1;

__global__ void __launch_bounds__(512, 2) fwd_kernel(Args args) {
    extern __shared__ __attribute__((aligned(16))) unsigned char lds_raw[];
    LAS unsigned char* lds = (LAS unsigned char*)lds_raw;
    volatile LAS unsigned* MISC = (volatile LAS unsigned*)(lds + MISC_OFF);
    const int tid0 = threadIdx.x;
    const int G = gridDim.x; const int bx = blockIdx.x; const int vcu = (G % 8 == 0) ? (bx % 8) * (G / 8) + bx / 8 : bx;
    const int NGW = G * 8;
    unsigned char* ws0 = args.ws;
    if (tid0 < 32) MISC[tid0] = 0u;
    LAS unsigned long long* TBL = (LAS unsigned long long*)(lds + MISC_OFF + 256);
    if (tid0 == 0) {
#define TB_ST(i) TBL[i] = (unsigned long long)(uintptr_t)args.in[i];
        TB_ST(0) TB_ST(1) TB_ST(2) TB_ST(3) TB_ST(4) TB_ST(5) TB_ST(6) TB_ST(7) TB_ST(8) TB_ST(9) TB_ST(10) TB_ST(11) TB_ST(12) TB_ST(13) TB_ST(14) TB_ST(15) TB_ST(16) TB_ST(17) TB_ST(18) TB_ST(19) TB_ST(20) TB_ST(21) TB_ST(22) TB_ST(23) TB_ST(24) TB_ST(25)
#undef TB_ST
    }
    __syncthreads();
    const int lo = args.ph_lo, hi = args.ph_hi;
    XcdBarrier bar; bar.bar = (unsigned*)(ws0 + WS_CTL) + CW_BAR; bar.x = 0; bar.st = nullptr;
    if (hi - lo > 1) bar = xcd_barrier_post((unsigned*)(ws0 + WS_CTL) + CW_BAR, MISC + 8);
#ifndef PHMASK
#define PHMASK 0xFFFFFFFFu
#endif
#define PH_BEGIN(k, kb) if (((PHMASK >> (kb)) & 1u) && lo <= (k) && (k) < hi) { int tid = tid0; asm volatile("" : "+v"(tid)); const int lane = tid & 63, wave = __builtin_amdgcn_readfirstlane(tid >> 6); const int gw = vcu * 8 + wave; \
    size_t zo = 0; asm volatile("" : "+s"(zo)); unsigned char* ws = ws0 + zo; float* X = (float*)(ws + WS_X); bf16* HN = (bf16*)(ws + WS_HN); bf16* HID = (bf16*)(ws + WS_HID); const float* MOD = (const float*)(ws + WS_MOD); unsigned char* act = ws + WS_ACT; const float* modl = MOD + (size_t)layer * 3 * 12288; (void)X; (void)HN; (void)HID; (void)act; (void)modl; (void)lane; (void)gw;
#define PH_END(k)   if ((k) + 1 < hi) xcd_barrier(bar); }

    int layer = 0;

    PH_BEGIN(0, 0) prologue_phase(TBL, ws, lds, tid, lane, wave, gw, NGW); PH_END(0)
    PH_BEGIN(1, 1) modreduce_phase(TBL, ws, vcu * 512 + tid, G * 512); PH_END(1)

#pragma unroll 1
    for (layer = 0; layer < DEPTH; ++layer) {
        const int kind = layer % 3, jj = layer / 3, pb = 2 + 8 * layer; const bool last = (layer == DEPTH - 1);
        PH_BEGIN(pb + 0, 2) norm_phase(lds, tid, lane, gw, NGW, X, HN, INP(I_NMG) + layer * DM, modl, 0, 2048, false); PH_END(pb + 0)
        size_t mixAoff, mixWoff; int mixK;
        if (kind == 0) {
#define DA_PTRS bf16 *Qd = (bf16*)act, *Kd = (bf16*)(act + A34), *Vd = (bf16*)(act + 2 * A34); float* OF = (float*)(act + 3 * A34); bf16* DAO = (bf16*)(act + 7 * A34); (void)Qd; (void)Kd; (void)Vd; (void)OF; (void)DAO;
            PH_BEGIN(pb + 1, 3) { DA_PTRS pg8::EpiQkvDa E{Qd, Kd, Vd, (const float*)(ws + WS_RCDA), (const float*)(ws + WS_RSDA)};
                run_gemm(tid, lds, G, HN, (const bf16*)(ws + WS_WQKV + (size_t)jj * 24 * MiB), 6144, 2048, false, E); } PH_END(pb + 1)
            PH_BEGIN(pb + 2, 4) { DA_PTRS da_attn_phase((char*)lds_raw, tid, vcu, G, Qd, Kd, Vd, OF, !last); } PH_END(pb + 2)
            PH_BEGIN(pb + 3, 5) { DA_PTRS da_combine_phase(lane, gw, NGW, OF, DAO, INP(I_DALAM) + jj * 512, INP(I_DASUB) + jj * 256, 0.8f - 0.6f * expf(-0.3f * (float)layer), !last); } PH_END(pb + 3)
            mixAoff = WS_ACT + 7 * A34; mixWoff = WS_WODA + (size_t)jj * 8 * MiB; mixK = 2048;
        } else if (kind == 1) {
#define SG_PTRS bf16 *Ud = (bf16*)act, *Vd = (bf16*)(act + A34), *Gd = (bf16*)(act + 2 * A34); float* VSS = (float*)(ws + WS_VSS); (void)Ud; (void)Vd; (void)Gd; (void)VSS;
            PH_BEGIN(pb + 1, 6) { SG_PTRS pg8::EpiSgIn E{Ud, Vd, VSS}; run_gemm(tid, lds, G, HN, (const bf16*)(ws + WS_WSGI), 4096, 2048, false, E); } PH_END(pb + 1)
            PH_BEGIN(pb + 2, 7) { SG_PTRS sg_phase(lds, tid, lane, wave, vcu, G, Ud, Vd, VSS, INP(I_SGWS), INP(I_SGBS), INP(I_SGVG), Gd); } PH_END(pb + 2)
            mixAoff = WS_ACT + 2 * A34; mixWoff = WS_WSGO; mixK = 2048;
        } else {
#define RT_PTRS bf16 *Qd = (bf16*)act, *Kd = (bf16*)(act + A34), *Vd = (bf16*)(act + 2 * A34), *Gt = (bf16*)(act + 4 * A34); float *OI = (float*)(act + 6 * A34), *ORr = (float*)(act + 10 * A34); bf16* RO = (bf16*)(act + 14 * A34); (void)Qd; (void)Kd; (void)Vd; (void)Gt; (void)OI; (void)ORr; (void)RO;
            PH_BEGIN(pb + 1, 8) { RT_PTRS pg8::EpiRet E{Qd, Kd, Vd, Gt, (const float*)(ws + WS_RCRT), (const float*)(ws + WS_RSRT)}; run_gemm(tid, lds, G, HN, (const bf16*)(ws + WS_WRET), 12288, 2048, false, E); } PH_END(pb + 1)
            PH_BEGIN(pb + 2, 9) { RT_PTRS ret_scan_phase(lds, tid, lane, wave, vcu, G, Qd, Kd, Vd, ORr, INP(I_RDEC));
                             ret_intra_phase(lds, tid, lane, wave, vcu, G, Qd, Kd, Vd, OI, INP(I_RDEC)); } PH_END(pb + 2)
            PH_BEGIN(pb + 3, 10) { RT_PTRS ret_gate_phase(lane, gw, NGW, OI, ORr, Gt, RO); } PH_END(pb + 3)
            mixAoff = WS_ACT + 14 * A34; mixWoff = WS_WRETO; mixK = 4096;
        }
        PH_BEGIN(pb + 4, 11) { pg8::EpiRes E{X, modl, 2 * 2048}; run_gemm(tid, lds, G, (const bf16*)(ws + mixAoff), (const bf16*)(ws + mixWoff), 2048, mixK, last, E); } PH_END(pb + 4)
        PH_BEGIN(pb + 5, 2) norm_phase(lds, tid, lane, gw, NGW, X, HN, INP(I_NFG) + layer * DM, modl, 3 * 2048, 4 * 2048, last); PH_END(pb + 5)
        PH_BEGIN(pb + 6, 12) { pg8::EpiSwiglu E{HID}; run_gemm(tid, lds, G, HN, (const bf16*)(ws + WS_WGU + (size_t)layer * 44 * MiB), 11264, 2048, last, E); } PH_END(pb + 6)
        PH_BEGIN(pb + 7, 13) { pg8::EpiRes E{X, modl, 5 * 2048}; run_gemm(tid, lds, G, HID, (const bf16*)(ws + WS_WD + (size_t)layer * 22 * MiB), 2048, FFH, last, E); } PH_END(pb + 7)
    }
    PH_BEGIN(N_PHASES - 1, 14) final_norm_phase(lane, gw, NGW, X, args.out, INP(I_FNG)); PH_END(N_PHASES - 1)
#undef PH_BEGIN
#undef PH_END
}

#ifndef ONE_LAUNCH
#define ONE_LAUNCH 0
#endif
extern "C" void kernel_launch(void* const* d_in, const int* in_sizes, int n_in, void* d_out, int out_size, void* d_ws, size_t ws_size, hipStream_t stream) {
    static int grid = 0;
    if (grid == 0) {
        if (n_in != 26 || out_size != NB * SEQ * DM || ws_size < WS_END) { fprintf(stderr, "kernel_launch: unexpected shapes (n_in %d, out %d, ws %zu < %zu)\n", n_in, out_size, ws_size, (size_t)WS_END); grid = -1; return; }
        int dev = 0, cus = 0;
        if (hipGetDevice(&dev) != hipSuccess || hipDeviceGetAttribute(&cus, hipDeviceAttributeMultiprocessorCount, dev) != hipSuccess) { grid = -1; return; }
        if (hipFuncSetAttribute((const void*)fwd_kernel, hipFuncAttributeMaxDynamicSharedMemorySize, LDS_BYTES) != hipSuccess) { fprintf(stderr, "kernel_launch: hipFuncSetAttribute failed\n"); grid = -1; return; }
        grid = cus;
    }
    if (grid < 0) return;
    (void)hipMemsetAsync((char*)d_ws + WS_CTL, 0, CTL_ZERO_BYTES, stream);
    Args a{};
    for (int i = 0; i < 26; ++i) a.in[i] = (const float*)d_in[i];
    a.out = (float*)d_out; a.ws = (unsigned char*)d_ws;
#if ONE_LAUNCH
    a.ph_lo = 0; a.ph_hi = N_PHASES;
    hipLaunchKernelGGL(fwd_kernel, dim3(grid), dim3(512), LDS_BYTES, stream, a);
#else
    for (int p = 0; p < N_PHASES; ++p) {
        if (p == 2 + 8 * 1 + 3) continue;
        a.ph_lo = p; a.ph_hi = p + 1;
        hipLaunchKernelGGL(fwd_kernel, dim3(grid), dim3(512), LDS_BYTES, stream, a);
    }
#endif
}
```

```cpp
#include <hip/hip_runtime.h>
#include <cstdio>
#include <cstdint>

constexpr int DM = 2048, NB = 2, SEQ = 4096, CTXL = 256, TB = SEQ + CTXL  , MALL = NB * TB  ;
constexpr int FFH = 5632, DEPTH = 4;
constexpr float EPSN = 1e-6f;

namespace pg8 {
#define PG8_LAS __attribute__((address_space(3)))
typedef unsigned short bf16_t;
typedef short bf16x8 __attribute__((ext_vector_type(8)));
typedef float f32x4 __attribute__((ext_vector_type(4)));
typedef unsigned u32x4 __attribute__((ext_vector_type(4)));
constexpr int BM = 256, BK = 64, HALF = 128, HTB = HALF * BK * 2  , STAGE_BYTES = 8 * HTB, NXCD = 8, WGM = 8;

__host__ __device__ __forceinline__ int lds_byte(int r, int c) { const int st = (r >> 4) * 2 + (c >> 5), rr = r & 15, cc = c & 31, ob = rr * 64 + cc * 2; return st * 1024 + (ob ^ (((ob >> 9) & 1) << 5)); }
__host__ __device__ __forceinline__ void stage_rc(int b, int& R, int& C) { const int st = b / 1024, sb = b % 1024, swz = sb ^ (((sb >> 9) & 1) << 5); R = (st >> 1) * 16 + swz / 64; C = (st & 1) * 32 + (swz % 64) / 2; }
__host__ __device__ __forceinline__ int perm32(int rho) { const int n = rho >> 4, i = rho & 15; return 8 * (i >> 2) + 4 * n + (i & 3); }

struct Unit { int pm, pn; };
struct Gemm { const bf16_t* A; const bf16_t* Bt; int M, N, K; };


struct Order {
    int nM, nN, nwg, G, c, skip;
    __device__ __forceinline__ void init(int nM_, int nN_, int G_, int c_, int skip_) { nM = nM_; nN = nN_; nwg = nM * nN; G = G_; c = c_; skip = skip_; }
    __device__ __forceinline__ bool next(int i, Unit& u) const {
        const long L = (long)i * G + c; if (L >= nwg) return false;
        int wgid = (int)L; { const int q = nwg / NXCD, r = nwg % NXCD, xcd = wgid % NXCD, off = wgid / NXCD; wgid = (xcd < r ? xcd * (q + 1) : r * (q + 1) + (xcd - r) * q) + off; }
        const int nig = WGM * nN, gid = wgid / nig, fm = gid * WGM, gsz = (nM - fm) < WGM ? (nM - fm) : WGM;
        int pm = fm + ((wgid % nig) % gsz); u.pn = (wgid % nig) / gsz;
        if (skip) pm = pm + 1 + (pm >= 16 ? 1 : 0);
        u.pm = pm; return true;
    }
    __device__ __forceinline__ void a_ready(const Unit&) const {}
    __device__ __forceinline__ void done(const Unit&) const {}
};

__device__ __forceinline__ unsigned cvt_pk_bf16(float lo, float hi) { unsigned r; asm volatile("v_cvt_pk_bf16_f32 %0, %1, %2" : "=v"(r) : "v"(lo), "v"(hi)); return r; }
typedef float f32x2 __attribute__((ext_vector_type(2)));
__device__ __forceinline__ f32x2 gelu_pk(f32x2 v) {
    const f32x2 av = __builtin_elementwise_abs(v), d = av * 0.2316418882f + 1.0f;
    f32x2 t; t.x = __builtin_amdgcn_rcpf(d.x); t.y = __builtin_amdgcn_rcpf(d.y);
    f32x2 q = t * 0.5307027145f + (-0.7265760135f); q = q * t + 0.7107068705f; q = q * t + (-0.142248368f); q = q * t + 0.127414796f; q = q * t;
    const f32x2 s = (v * v) * (-0.72134752044f);
    f32x2 e; e.x = __builtin_amdgcn_exp2f(s.x); e.y = __builtin_amdgcn_exp2f(s.y);
    const f32x2 m = v * (q * e), r = v - m;
    f32x2 o; o.x = v.x < 0.f ? m.x : r.x; o.y = v.y < 0.f ? m.y : r.y; return o;
}
__device__ __forceinline__ f32x4 gelu4(f32x4 v) { const f32x2 a = gelu_pk((f32x2){v[0], v[1]}), b = gelu_pk((f32x2){v[2], v[3]}); return (f32x4){a.x, a.y, b.x, b.y}; }
__device__ __forceinline__ float silu1(float x) { return x * __builtin_amdgcn_rcpf(1.0f + __builtin_amdgcn_exp2f(-1.4426950408889634f * x)); }
__device__ __forceinline__ f32x4 silu4(f32x4 v) { return (f32x4){silu1(v[0]), silu1(v[1]), silu1(v[2]), silu1(v[3])}; }
__device__ __forceinline__ u32x4 pack8(f32x4 a, f32x4 b) { u32x4 w; w.x = cvt_pk_bf16(a[0], a[1]); w.y = cvt_pk_bf16(a[2], a[3]); w.z = cvt_pk_bf16(b[0], b[1]); w.w = cvt_pk_bf16(b[2], b[3]); return w; }
__device__ __forceinline__ int cvec_of_panel(int pm) { return (pm % 17 == 0) ? 2 : pm / 17; }

struct EpiRes {
    static constexpr bool PERM = false, AFTER_DRAIN = false;
    float* X; const float* modl; int gofs;
    __device__ __forceinline__ void operator()(const f32x4 (&acc)[2][2][4][2], const Unit& u, int wr, int wc, int fr, int fq) const {
        const float* gate = modl + cvec_of_panel(u.pm) * 12288 + gofs;
        const int row0 = u.pm * BM + wr * 64 + fr, col0 = u.pn * BM + wc * 32 + 4 * fq;
        f32x4 gv[2][2];
#pragma unroll
        for (int bj = 0; bj < 2; ++bj)
#pragma unroll
            for (int n = 0; n < 2; ++n) gv[bj][n] = *(const f32x4*)(gate + col0 + bj * HALF + n * 16);
#pragma unroll
        for (int ai = 0; ai < 2; ++ai)
#pragma unroll
            for (int m = 0; m < 4; ++m) { float* rowp = X + (size_t)(row0 + ai * HALF + m * 16) * DM + col0;
#pragma unroll
                for (int bj = 0; bj < 2; ++bj)
#pragma unroll
                    for (int n = 0; n < 2; ++n) { f32x4* p = (f32x4*)(rowp + bj * HALF + n * 16); *p = *p + gv[bj][n] * acc[ai][bj][m][n]; } }
    }
};
struct EpiSwiglu {
    static constexpr bool PERM = true, AFTER_DRAIN = false;
    bf16_t* H;
    __device__ __forceinline__ void operator()(const f32x4 (&acc)[2][2][4][2], const Unit& u, int wr, int wc, int fr, int fq) const {
        const int row0 = u.pm * BM + wr * 64 + fr, col0 = u.pn * HALF + wc * 32 + 8 * fq;
#pragma unroll
        for (int ai = 0; ai < 2; ++ai)
#pragma unroll
            for (int m = 0; m < 4; ++m) { bf16_t* rowp = H + (size_t)(row0 + ai * HALF + m * 16) * FFH + col0;
                const f32x4 o0 = silu4(acc[ai][0][m][0]) * acc[ai][1][m][0], o1 = silu4(acc[ai][0][m][1]) * acc[ai][1][m][1];
                *(u32x4*)rowp = pack8(o0, o1); }
    }
};
struct EpiQkvDa {
    static constexpr bool PERM = true, AFTER_DRAIN = false;
    bf16_t *Q, *K, *V; const float *rc, *rs;
    __device__ __forceinline__ void operator()(const f32x4 (&acc)[2][2][4][2], const Unit& u, int wr, int wc, int fr, int fq) const {
        const int row0 = u.pm * BM + wr * 64 + fr;
        if (u.pn >= 16) {
            const int col0 = (u.pn - 16) * BM + wc * 32 + 8 * fq;
#pragma unroll
            for (int ai = 0; ai < 2; ++ai)
#pragma unroll
                for (int m = 0; m < 4; ++m) { bf16_t* rowp = V + (size_t)(row0 + ai * HALF + m * 16) * DM + col0;
#pragma unroll
                    for (int bj = 0; bj < 2; ++bj) *(u32x4*)(rowp + bj * HALF) = pack8(acc[ai][bj][m][0], acc[ai][bj][m][1]); }
        } else {
            bf16_t* dst = (u.pn < 8) ? Q : K; const int h = u.pn & 7;
            const bool lat = (u.pm % 17) != 0; const int tb = (u.pm / 17) * TB + CTXL;
            const int mp = wc >> 1, dd0 = (wc & 1) * 32 + 8 * fq, colb = h * 256 + mp * 128 + dd0;
#pragma unroll
            for (int ai = 0; ai < 2; ++ai)
#pragma unroll
                for (int m = 0; m < 4; ++m) { const int row = row0 + ai * HALF + m * 16;
                    f32x4 o1a = acc[ai][0][m][0], o1b = acc[ai][0][m][1], o2a = acc[ai][1][m][0], o2b = acc[ai][1][m][1];
                    if (lat) { const size_t to = (size_t)(row - tb) * 64 + dd0;
                        const f32x4 ca = *(const f32x4*)(rc + to), cb = *(const f32x4*)(rc + to + 4), sa = *(const f32x4*)(rs + to), sb = *(const f32x4*)(rs + to + 4);
                        const f32x4 x1a = o1a, x1b = o1b, x2a = o2a, x2b = o2b;
                        o1a = x1a * ca - x2a * sa; o2a = x1a * sa + x2a * ca; o1b = x1b * cb - x2b * sb; o2b = x1b * sb + x2b * cb; }
                    bf16_t* rowp = dst + (size_t)row * DM + colb;
                    *(u32x4*)rowp = pack8(o1a, o1b); *(u32x4*)(rowp + 64) = pack8(o2a, o2b); }
        }
    }
};
struct EpiSgIn {
    static constexpr bool PERM = true, AFTER_DRAIN = false;
    bf16_t *U, *V; float* VSS;
    __device__ __forceinline__ void operator()(const f32x4 (&acc)[2][2][4][2], const Unit& u, int wr, int wc, int fr, int fq) const {
        const int row0 = u.pm * BM + wr * 64 + fr; const bool isv = u.pn >= 8;
        bf16_t* dst = isv ? V : U; const int col0 = (u.pn & 7) * BM + wc * 32 + 8 * fq;
#pragma unroll
        for (int ai = 0; ai < 2; ++ai)
#pragma unroll
            for (int m = 0; m < 4; ++m) { const int row = row0 + ai * HALF + m * 16; bf16_t* rowp = dst + (size_t)row * DM + col0; float ss = 0.f;
#pragma unroll
                for (int bj = 0; bj < 2; ++bj) { const f32x4 v0 = gelu4(acc[ai][bj][m][0]), v1 = gelu4(acc[ai][bj][m][1]);
                    ss += (v0[0] * v0[0] + v0[1] * v0[1]) + (v0[2] * v0[2] + v0[3] * v0[3]) + (v1[0] * v1[0] + v1[1] * v1[1]) + (v1[2] * v1[2] + v1[3] * v1[3]);
                    *(u32x4*)(rowp + bj * HALF) = pack8(v0, v1); }
                if (isv) { ss += __shfl_xor(ss, 16); ss += __shfl_xor(ss, 32); if (fq == 0) VSS[(size_t)row * 32 + (u.pn - 8) * 4 + wc] = ss; } }
    }
};
struct EpiRet {
    static constexpr bool PERM = true, AFTER_DRAIN = false;
    bf16_t *Q, *K, *V, *Gt; const float *rc, *rs;
    __device__ __forceinline__ void operator()(const f32x4 (&acc)[2][2][4][2], const Unit& u, int wr, int wc, int fr, int fq) const {
        const int row0 = u.pm * BM + wr * 64 + fr;
        if (u.pn >= 16) {
            const bool isg = u.pn >= 32; bf16_t* dst = isg ? Gt : V; const int col0 = ((u.pn - 16) & 15) * BM + wc * 32 + 8 * fq;
#pragma unroll
            for (int ai = 0; ai < 2; ++ai)
#pragma unroll
                for (int m = 0; m < 4; ++m) { bf16_t* rowp = dst + (size_t)(row0 + ai * HALF + m * 16) * 4096 + col0;
#pragma unroll
                    for (int bj = 0; bj < 2; ++bj) { f32x4 v0 = acc[ai][bj][m][0], v1 = acc[ai][bj][m][1]; if (isg) { v0 = silu4(v0); v1 = silu4(v1); }
                        *(u32x4*)(rowp + bj * HALF) = pack8(v0, v1); } }
        } else {
            const bool isk = u.pn >= 8; bf16_t* dst = isk ? K : Q; const int h = u.pn & 7; const float sc = isk ? 0.0625f : 1.0f;
            const bool lat = (u.pm % 17) != 0; const int tb = (u.pm / 17) * TB + CTXL;
            const int p0 = wc * 32 + 8 * fq, colb = h * 256 + p0;
#pragma unroll
            for (int ai = 0; ai < 2; ++ai)
#pragma unroll
                for (int m = 0; m < 4; ++m) { const int row = row0 + ai * HALF + m * 16;
                    f32x4 o1a = acc[ai][0][m][0], o1b = acc[ai][0][m][1], o2a = acc[ai][1][m][0], o2b = acc[ai][1][m][1];
                    if (lat) { const size_t to = (size_t)(row - tb) * 128 + p0;
                        const f32x4 ca = *(const f32x4*)(rc + to), cb = *(const f32x4*)(rc + to + 4), sa = *(const f32x4*)(rs + to), sb = *(const f32x4*)(rs + to + 4);
                        const f32x4 x1a = o1a, x1b = o1b, x2a = o2a, x2b = o2b;
                        o1a = x1a * ca - x2a * sa; o2a = x1a * sa + x2a * ca; o1b = x1b * cb - x2b * sb; o2b = x1b * sb + x2b * cb; }
                    bf16_t* rowp = dst + (size_t)row * DM + colb;
                    *(u32x4*)rowp = pack8(o1a * sc, o1b * sc); *(u32x4*)(rowp + 128) = pack8(o2a * sc, o2b * sc); }
        }
    }
};

template <class Epi, class Sched, bool ALIGN_EPI = false, bool SP2 = false>
__device__ __forceinline__ void gemm_phase(const int tid, PG8_LAS unsigned char* lds, const Gemm g, const Sched& S, const Epi& E) {
    const int wid = __builtin_amdgcn_readfirstlane(tid >> 6), lane = tid & 63, wr = wid >> 2, wc = wid & 3, fr = lane & 15, fq = lane >> 4;
    const int K = g.K, nt = K / BK;
    unsigned voffA[2], voffB[2];
#pragma unroll
    for (int i = 0; i < 2; ++i) { int R, C; stage_rc(tid * 16 + i * 8192, R, C); const int Rb = Epi::PERM ? ((R & ~31) + perm32(R & 31)) : R;
        voffA[i] = (unsigned)(R * K + C) * 2u; voffB[i] = (unsigned)(Rb * K + C) * 2u; }
    const size_t kstep = (size_t)(BK * 2);
    const size_t hstep = (size_t)HALF * K * 2;
    const size_t tstep = 2 * hstep;
    const unsigned ldsw = (unsigned)wid * 1024u;
    const int aoff = lds_byte(wr * 64 + fr, fq * 8), boff = lds_byte(wc * 32 + fr, fq * 8);
#define PG8_SA(b, h) (((b) * 2 + (h)) * HTB)
#define PG8_SB(b, h) ((4 + (b) * 2 + (h)) * HTB)
#define PG8_STAGE(bufoff, gbase, voff) do { _Pragma("unroll") for (int _i = 0; _i < 2; ++_i) \
        __builtin_amdgcn_global_load_lds((const unsigned*)((const char*)(gbase) + (voff)[_i]), (PG8_LAS unsigned*)(lds + (bufoff) + ldsw + _i * 8192), 16, 0, 0); } while (0)
#define PG8_LDA(dst, b, h) do { _Pragma("unroll") for (int m = 0; m < 4; ++m) _Pragma("unroll") for (int k = 0; k < 2; ++k) dst[m][k] = *(const PG8_LAS bf16x8*)(lds + PG8_SA(b, h) + aoff + m * 2048 + k * 1024); } while (0)
#define PG8_LDB(dst, b, h) do { _Pragma("unroll") for (int n = 0; n < 2; ++n) _Pragma("unroll") for (int k = 0; k < 2; ++k) dst[n][k] = *(const PG8_LAS bf16x8*)(lds + PG8_SB(b, h) + boff + n * 2048 + k * 1024); } while (0)
#define PG8_MMA(ai, bj, At, Bt) do { __builtin_amdgcn_s_setprio(1); _Pragma("unroll") for (int m = 0; m < 4; ++m) _Pragma("unroll") for (int n = 0; n < 2; ++n) _Pragma("unroll") for (int k = 0; k < 2; ++k) \
        acc[ai][bj][m][n] = __builtin_amdgcn_mfma_f32_16x16x32_bf16(Bt[n][k], At[m][k], acc[ai][bj][m][n], 0, 0, 0); __builtin_amdgcn_s_setprio(0); } while (0)
#define PG8_WAIT_V(n) asm volatile("s_waitcnt vmcnt(" #n ")" ::: "memory")
#define PG8_WAIT_L(n) asm volatile("s_waitcnt lgkmcnt(" #n ")" ::: "memory")
#define PG8_BAR __builtin_amdgcn_s_barrier()
#define PG8_SCHED __builtin_amdgcn_sched_barrier(0)
    Unit cur, nxt; int ui = 0;
    if (!S.next(0, cur)) return;
    f32x4 acc[2][2][4][2];
#pragma unroll
    for (int a = 0; a < 2; ++a)
#pragma unroll
        for (int b = 0; b < 2; ++b)
#pragma unroll
            for (int m = 0; m < 4; ++m)
#pragma unroll
                for (int n = 0; n < 2; ++n) acc[a][b][m][n] = (f32x4){0.f, 0.f, 0.f, 0.f};
    bf16x8 At[4][2], B0[2][2], B1[2][2];
    const char* cA = (const char*)g.A + (size_t)cur.pm * tstep; const char* cB = (const char*)g.Bt + (size_t)cur.pn * tstep;
    S.a_ready(cur);
    if constexpr (SP2) {
        PG8_STAGE(PG8_SB(0, 0), cB, voffB); PG8_STAGE(PG8_SB(0, 1), cB + hstep, voffB); PG8_STAGE(PG8_SA(0, 0), cA, voffA); PG8_STAGE(PG8_SA(0, 1), cA + hstep, voffA);
        if (wr == 1) PG8_BAR;
        PG8_WAIT_V(2); PG8_BAR;
        PG8_STAGE(PG8_SB(1, 0), cB + kstep, voffB); PG8_STAGE(PG8_SA(1, 0), cA + kstep, voffA); PG8_STAGE(PG8_SB(1, 1), cB + hstep + kstep, voffB);
        PG8_WAIT_V(6); PG8_BAR;
    } else {
        PG8_STAGE(PG8_SB(0, 0), cB, voffB); PG8_STAGE(PG8_SA(0, 0), cA, voffA); PG8_STAGE(PG8_SB(0, 1), cB + hstep, voffB); PG8_STAGE(PG8_SA(0, 1), cA + hstep, voffA);
        if (wr == 1) PG8_BAR;
        PG8_WAIT_V(4); PG8_BAR;
        PG8_STAGE(PG8_SB(1, 0), cB + kstep, voffB); PG8_STAGE(PG8_SA(1, 0), cA + kstep, voffA); PG8_STAGE(PG8_SB(1, 1), cB + hstep + kstep, voffB);
        PG8_WAIT_V(6); PG8_BAR;
    }
    for (;;) {
        const bool has_next = S.next(ui + 1, nxt);
        const char* nA = has_next ? (const char*)g.A + (size_t)nxt.pm * tstep : cA; const char* nB = has_next ? (const char*)g.Bt + (size_t)nxt.pn * tstep : cB;
        for (int t = 0; t < nt; t += 2) {
            const bool last = (t == nt - 2);
            const char* a1 = cA + (size_t)(t + 1) * kstep;
            const char* a2 = last ? nA : cA + (size_t)(t + 2) * kstep; const char* b2 = last ? nB : cB + (size_t)(t + 2) * kstep;
            const char* a3 = a2 + kstep; const char* b3 = b2 + kstep;
            if (last && has_next) S.a_ready(nxt);
            if constexpr (SP2) {
            PG8_LDB(B0, 0, 0); PG8_LDB(B1, 0, 1); PG8_SCHED; PG8_LDA(At, 0, 0); PG8_STAGE(PG8_SA(1, 1), a1 + hstep, voffA);
            PG8_WAIT_V(8); PG8_WAIT_L(0); PG8_BAR; PG8_MMA(0, 0, At, B0); PG8_MMA(0, 1, At, B1); PG8_BAR; PG8_SCHED;
            PG8_LDA(At, 0, 1); PG8_STAGE(PG8_SB(0, 0), b2, voffB); PG8_STAGE(PG8_SB(0, 1), b2 + hstep, voffB); PG8_STAGE(PG8_SA(0, 0), a2, voffA);
            PG8_WAIT_V(8); PG8_WAIT_L(0); PG8_BAR; PG8_MMA(1, 0, At, B0); PG8_MMA(1, 1, At, B1); PG8_BAR; PG8_SCHED;
            PG8_LDB(B0, 1, 0); PG8_LDB(B1, 1, 1); PG8_SCHED; PG8_LDA(At, 1, 0); PG8_STAGE(PG8_SA(0, 1), a2 + hstep, voffA);
            PG8_WAIT_V(8); PG8_WAIT_L(0); PG8_BAR; PG8_MMA(0, 0, At, B0); PG8_MMA(0, 1, At, B1); PG8_BAR; PG8_SCHED;
            PG8_LDA(At, 1, 1); PG8_STAGE(PG8_SB(1, 0), b3, voffB); PG8_STAGE(PG8_SB(1, 1), b3 + hstep, voffB); PG8_STAGE(PG8_SA(1, 0), a3, voffA);
            PG8_WAIT_V(8); PG8_WAIT_L(0); PG8_BAR; PG8_MMA(1, 0, At, B0); PG8_MMA(1, 1, At, B1); PG8_BAR; PG8_SCHED;
            } else {
            PG8_LDB(B0, 0, 0); PG8_SCHED; PG8_LDA(At, 0, 0); PG8_STAGE(PG8_SA(1, 1), a1 + hstep, voffA);
            PG8_WAIT_L(8); PG8_BAR; PG8_WAIT_L(0); PG8_MMA(0, 0, At, B0); PG8_BAR; PG8_SCHED;
            PG8_LDB(B1, 0, 1); PG8_STAGE(PG8_SB(0, 0), b2, voffB);
            PG8_BAR; PG8_WAIT_L(0); PG8_MMA(0, 1, At, B1); PG8_BAR;
            PG8_LDA(At, 0, 1); PG8_STAGE(PG8_SA(0, 0), a2, voffA);
            PG8_BAR; PG8_WAIT_L(0); PG8_MMA(1, 0, At, B0); PG8_BAR; PG8_SCHED;
            PG8_STAGE(PG8_SB(0, 1), b2 + hstep, voffB);
            PG8_WAIT_V(6); PG8_BAR; PG8_MMA(1, 1, At, B1); PG8_BAR;
            PG8_LDB(B0, 1, 0); PG8_SCHED; PG8_LDA(At, 1, 0); PG8_STAGE(PG8_SA(0, 1), a2 + hstep, voffA);
            PG8_WAIT_L(8); PG8_BAR; PG8_WAIT_L(0); PG8_MMA(0, 0, At, B0); PG8_BAR; PG8_SCHED;
            PG8_LDB(B1, 1, 1); PG8_STAGE(PG8_SB(1, 0), b3, voffB);
            PG8_BAR; PG8_WAIT_L(0); PG8_MMA(0, 1, At, B1); PG8_BAR;
            PG8_LDA(At, 1, 1); PG8_STAGE(PG8_SA(1, 0), a3, voffA);
            PG8_BAR; PG8_WAIT_L(0); PG8_MMA(1, 0, At, B0); PG8_BAR; PG8_SCHED;
            PG8_STAGE(PG8_SB(1, 1), b3 + hstep, voffB);
            PG8_WAIT_V(6); PG8_BAR; PG8_MMA(1, 1, At, B1); PG8_BAR;
            }
        }
        if constexpr (ALIGN_EPI) { if (wr == 0) PG8_BAR; }
        if constexpr (!Epi::AFTER_DRAIN) { E(acc, cur, wr, wc, fr, fq); S.done(cur); }
        if (!has_next) break;
#pragma unroll
        for (int a = 0; a < 2; ++a)
#pragma unroll
            for (int b = 0; b < 2; ++b)
#pragma unroll
                for (int m = 0; m < 4; ++m)
#pragma unroll
                    for (int n = 0; n < 2; ++n) acc[a][b][m][n] = (f32x4){0.f, 0.f, 0.f, 0.f};
        cur = nxt; cA = nA; cB = nB; ++ui;
        if constexpr (ALIGN_EPI) { if (wr == 1) PG8_BAR; }
    }
    PG8_WAIT_V(0);
    if constexpr (!ALIGN_EPI) { if (wr == 0) PG8_BAR; }
    PG8_BAR;
    if constexpr (Epi::AFTER_DRAIN) { E.fused(acc, cur, wr, wc, fr, fq, lds, wid, lane); S.done(cur); }
#undef PG8_SA
#undef PG8_SB
#undef PG8_STAGE
#undef PG8_LDA
#undef PG8_LDB
#undef PG8_MMA
#undef PG8_WAIT_V
#undef PG8_WAIT_L
#undef PG8_BAR
#undef PG8_SCHED
}
}
namespace att {
typedef unsigned short bf16;
constexpr int   D = 128, NW = 8, QBLK = 32, KVBLK = 64;
constexpr float SCALE = 0.088388347648318440f;
constexpr float THR = 8.f;
#ifndef ATT_SDEPTH
#define ATT_SDEPTH 1
#endif
constexpr int SDEPTH = ATT_SDEPTH;
constexpr size_t SHM_V = KVBLK * D * 2, SHM_K = KVBLK * D * 2, SHM_ATTN = 2 * SHM_V + 2 * SHM_K + NW * 64 * 4;
using bf16x8 = __attribute__((ext_vector_type(8))) short;
using s16x4  = __attribute__((ext_vector_type(4))) short;
using f32x16 = __attribute__((ext_vector_type(16))) float;
using f32x8  = __attribute__((ext_vector_type(8))) float;
using u32x4  = __attribute__((ext_vector_type(4))) unsigned;
#define KSWZ(row, colB) ((row) * 256 + ((colB) ^ (((row) & 7) << 4)))
#define SBAR() __builtin_amdgcn_sched_barrier(0)
__device__ __forceinline__ int crow(int r, int hi) { return (r & 3) + 8 * (r >> 2) + 4 * hi; }
__device__ __forceinline__ unsigned cvtpk(float lo, float hi) {
  unsigned r; asm volatile("v_cvt_pk_bf16_f32 %0, %1, %2" : "=v"(r) : "v"(lo), "v"(hi)); return r;
}
__device__ __forceinline__ void partialSM(f32x16& p0, f32x16& p1, float& m_reg, float& mn, float& alpha) {
  constexpr float C = SCALE * 1.4426950408889634f;
  float pmax = p0[0]; for (int r = 1; r < 16; ++r) pmax = fmaxf(pmax, p0[r]); for (int r = 0; r < 16; ++r) pmax = fmaxf(pmax, p1[r]);
  { auto rr = __builtin_amdgcn_permlane32_swap(__float_as_uint(pmax), __float_as_uint(pmax), false, false);
    pmax = fmaxf(__uint_as_float(rr[0]), __uint_as_float(rr[1])); }
  if (__builtin_expect(__all(pmax - m_reg <= THR / SCALE), 1)) { mn = m_reg; alpha = 1.f; }
  else { mn = fmaxf(m_reg, pmax); alpha = __builtin_amdgcn_exp2f((m_reg - mn) * C); m_reg = mn; }
  float mnC = -mn * C;
  for (int r = 0; r < 16; ++r) p0[r] = fmaf(p0[r], C, mnC); for (int r = 0; r < 16; ++r) p1[r] = fmaf(p1[r], C, mnC);
  for (int r = 0; r < 16; ++r) p0[r] = __builtin_amdgcn_exp2f(p0[r]);
}
__device__ __forceinline__ void finishSM(f32x16& p0, f32x16& p1, float alpha, float& l_reg, bf16x8& pa0, bf16x8& pa1, bf16x8& pa2, bf16x8& pa3) {
  for (int r = 0; r < 16; ++r) p1[r] = __builtin_amdgcn_exp2f(p1[r]);
  float ps = 0; for (int r = 0; r < 16; ++r) ps += p0[r]; for (int r = 0; r < 16; ++r) ps += p1[r];
  { auto rr = __builtin_amdgcn_permlane32_swap(__float_as_uint(ps), __float_as_uint(ps), false, false);
    ps = __uint_as_float(rr[0]) + __uint_as_float(rr[1]); }
  l_reg = l_reg * alpha + ps;
#define PK4(P, BASE, OUT) do { unsigned a0 = cvtpk(P[BASE + 0], P[BASE + 1]), a1 = cvtpk(P[BASE + 2], P[BASE + 3]);   \
    unsigned b0 = cvtpk(P[BASE + 4], P[BASE + 5]), b1 = cvtpk(P[BASE + 6], P[BASE + 7]);                              \
    auto r0 = __builtin_amdgcn_permlane32_swap(a0, b0, false, false); auto r1 = __builtin_amdgcn_permlane32_swap(a1, b1, false, false); \
    u32x4 w = {r0[0], r1[0], r0[1], r1[1]}; OUT = *reinterpret_cast<bf16x8*>(&w); } while (0)
  PK4(p0, 0, pa0); PK4(p0, 8, pa1); PK4(p1, 0, pa2); PK4(p1, 8, pa3);
#undef PK4
}
__device__ __forceinline__ void qkt(f32x16& p0, f32x16& p1, const bf16* Ks, const bf16x8* qr, int r32, int hi) {
  p0 = f32x16{}; p1 = f32x16{};
  for (int d0 = 0; d0 < 8; ++d0) { int cb = (d0 * 16 + hi * 8) * 2;
    bf16x8 b0 = *reinterpret_cast<const bf16x8*>((const char*)Ks + KSWZ(r32, cb));
    bf16x8 b1 = *reinterpret_cast<const bf16x8*>((const char*)Ks + KSWZ(32 + r32, cb));
    p0 = __builtin_amdgcn_mfma_f32_32x32x16_bf16(b0, qr[d0], p0, 0, 0, 0);
    p1 = __builtin_amdgcn_mfma_f32_32x32x16_bf16(b1, qr[d0], p1, 0, 0, 0); }
}
__device__ __forceinline__ int v_st(int k, int c) { const int kk = (k & ~0xC) | ((k & 4) << 1) | ((k & 8) >> 1); return ((kk >> 3) * 4 + (c >> 5)) * 512 + ((kk & 7) * 32 + (c & 31)) * 2; }
__device__ __forceinline__ int v_rd_base(int lane) { return ((lane & 3) << 3) | (((lane >> 2) & 3) << 6) | (((lane >> 4) & 1) << 5) | (((lane >> 5) & 1) << 8); }
constexpr int v_rd_off(int d0, int ks, int half) { return d0 * 512 + ks * 4096 + half * 2048; }
template <int OFF> __device__ __forceinline__ s16x4 tr_read(int vb) {
  s16x4 r; asm volatile("ds_read_b64_tr_b16 %0, %1 offset:%2" : "=&v"(r) : "v"(vb), "i"(OFF) : "memory"); return r;
}
template <int D0> __device__ __forceinline__ void pv_one(f32x16& od, int vb, bf16x8 pa0, bf16x8 pa1, bf16x8 pa2, bf16x8 pa3) {
  const s16x4 l0 = tr_read<v_rd_off(D0, 0, 0)>(vb), h0 = tr_read<v_rd_off(D0, 0, 1)>(vb), l1 = tr_read<v_rd_off(D0, 1, 0)>(vb), h1 = tr_read<v_rd_off(D0, 1, 1)>(vb);
  const s16x4 l2 = tr_read<v_rd_off(D0, 2, 0)>(vb), h2 = tr_read<v_rd_off(D0, 2, 1)>(vb), l3 = tr_read<v_rd_off(D0, 3, 0)>(vb), h3 = tr_read<v_rd_off(D0, 3, 1)>(vb);
  asm volatile("s_waitcnt lgkmcnt(0)" ::: "memory"); SBAR();
#define PK(L, H) (bf16x8){L[0], L[1], L[2], L[3], H[0], H[1], H[2], H[3]}
  od = __builtin_amdgcn_mfma_f32_32x32x16_bf16(pa0, PK(l0, h0), od, 0, 0, 0);
  od = __builtin_amdgcn_mfma_f32_32x32x16_bf16(pa1, PK(l1, h1), od, 0, 0, 0);
  od = __builtin_amdgcn_mfma_f32_32x32x16_bf16(pa2, PK(l2, h2), od, 0, 0, 0);
  od = __builtin_amdgcn_mfma_f32_32x32x16_bf16(pa3, PK(l3, h3), od, 0, 0, 0);
#undef PK
}
__device__ __forceinline__ void pv_d0(f32x16* o, int vb, bf16x8 pa0, bf16x8 pa1, bf16x8 pa2, bf16x8 pa3) {
  pv_one<0>(o[0], vb, pa0, pa1, pa2, pa3); pv_one<1>(o[1], vb, pa0, pa1, pa2, pa3); pv_one<2>(o[2], vb, pa0, pa1, pa2, pa3); pv_one<3>(o[3], vb, pa0, pa1, pa2, pa3);
}

template <int LDQ, int LDK, int LDO>
__device__ __forceinline__ void attn_dense_body(const int tid, const bf16* __restrict__ Qb, const bf16* __restrict__ Kh, const bf16* __restrict__ Vh,
                                                float* __restrict__ Ob, int seq, char* lds) {

  const int wid = tid >> 6, lane = tid & 63, r32 = lane & 31, hi = lane >> 5;
  bf16* V_lds = (bf16*)lds; bf16* K_lds = (bf16*)(lds + 2 * SHM_V);
  float* ws = (float*)(lds + 2 * SHM_V + 2 * SHM_K) + wid * 64; float* li_l = ws; float* al_l = ws + 32;
  float m_reg = -1e30f, l_reg = 0; f32x16 o[4] = {}; bf16x8 qr[8];
  const bf16* Qw = Qb + (long)(wid * QBLK + r32) * LDQ + hi * 8;
#pragma unroll
  for (int d0 = 0; d0 < 8; ++d0) qr[d0] = *reinterpret_cast<const bf16x8*>(Qw + d0 * 16);
  const int sr = tid >> 4, sc = (tid & 15) * 8, vst0 = v_st(sr, sc), vst1 = v_st(32 + sr, sc);
  const int vb0 = (int)(uintptr_t)V_lds + v_rd_base(lane);
  struct { bf16x8 vs0, vs1, ks0, ks1; } sr_[SDEPTH];
#define SLOAD(i, k0) do { sr_[i].vs0 = (*reinterpret_cast<const bf16x8*>(&Vh[(long)((k0) + sr) * LDK + sc])); sr_[i].vs1 = (*reinterpret_cast<const bf16x8*>(&Vh[(long)((k0) + 32 + sr) * LDK + sc])); \
    sr_[i].ks0 = (*reinterpret_cast<const bf16x8*>(&Kh[(long)((k0) + sr) * LDK + sc])); sr_[i].ks1 = (*reinterpret_cast<const bf16x8*>(&Kh[(long)((k0) + 32 + sr) * LDK + sc])); } while (0)
#define SWRITE(b, i) do { *(bf16x8*)((char*)V_lds + (b) * SHM_V + vst0) = sr_[i].vs0;          \
    *(bf16x8*)((char*)V_lds + (b) * SHM_V + vst1) = sr_[i].vs1; int kc = sc * 2;               \
    *(bf16x8*)((char*)K_lds + (b) * SHM_K + KSWZ(sr, kc)) = sr_[i].ks0;                       \
    *(bf16x8*)((char*)K_lds + (b) * SHM_K + KSWZ(32 + sr, kc)) = sr_[i].ks1; } while (0)
#define SWAIT() do { if constexpr (SDEPTH == 2) asm volatile("s_waitcnt vmcnt(4)" ::: "memory"); else asm volatile("s_waitcnt vmcnt(0)" ::: "memory"); } while (0)
#define RESC(a) do { if (__any((a) < 1.f)) { if (hi == 0) al_l[r32] = (a); asm volatile("s_waitcnt lgkmcnt(0)" ::: "memory"); \
    for (int d = 0; d < 4; ++d) for (int r = 0; r < 16; ++r) o[d][r] *= al_l[crow(r, hi)]; } } while (0)
  f32x16 pA0, pA1, pB0, pB1; float mnA, mnB, alA, alB; bf16x8 pa0, pa1, pa2, pa3; const int NT = seq / KVBLK;
  constexpr int SE = 0, SO = SDEPTH - 1;
  SLOAD(SE, 0); asm volatile("s_waitcnt vmcnt(0)" ::: "memory"); SWRITE(0, SE); __syncthreads();
  qkt(pA0, pA1, K_lds, qr, r32, hi); partialSM(pA0, pA1, m_reg, mnA, alA);
  SLOAD(SO, KVBLK); if constexpr (SDEPTH == 2) { if (2 < NT) SLOAD(SE, 2 * KVBLK); }
  SWAIT(); SWRITE(1, SO); __syncthreads();
  for (int j = 1; j + 1 < NT; j += 2) {
    SBAR(); qkt(pB0, pB1, (bf16*)((char*)K_lds + SHM_K), qr, r32, hi);
    finishSM(pA0, pA1, alA, l_reg, pa0, pa1, pa2, pa3); SBAR();
    SLOAD(SO, (j + SDEPTH) * KVBLK); SBAR();
    pv_d0(o, vb0, pa0, pa1, pa2, pa3); partialSM(pB0, pB1, m_reg, mnB, alB);
    __syncthreads(); SWAIT(); SWRITE(0, SE);
    RESC(alB); __syncthreads();
    SBAR(); qkt(pA0, pA1, K_lds, qr, r32, hi);
    finishSM(pB0, pB1, alB, l_reg, pa0, pa1, pa2, pa3); SBAR();
    if (SDEPTH == 1 || j + 3 < NT) SLOAD(SE, (j + 1 + SDEPTH) * KVBLK); SBAR();
    pv_d0(o, vb0 + (int)SHM_V, pa0, pa1, pa2, pa3); partialSM(pA0, pA1, m_reg, mnA, alA);
    __syncthreads(); SWAIT(); SWRITE(1, SO);
    RESC(alA); __syncthreads();
  }
  SBAR(); qkt(pB0, pB1, (bf16*)((char*)K_lds + SHM_K), qr, r32, hi);
  finishSM(pA0, pA1, alA, l_reg, pa0, pa1, pa2, pa3); SBAR();
  pv_d0(o, vb0, pa0, pa1, pa2, pa3); partialSM(pB0, pB1, m_reg, mnB, alB);
  __syncthreads(); RESC(alB);
  finishSM(pB0, pB1, alB, l_reg, pa0, pa1, pa2, pa3); SBAR();
  pv_d0(o, vb0 + (int)SHM_V, pa0, pa1, pa2, pa3);
  if (hi == 0) li_l[r32] = l_reg; asm volatile("s_waitcnt lgkmcnt(0)" ::: "memory");
  float rli[16];
#pragma unroll
  for (int r = 0; r < 16; ++r) rli[r] = __builtin_amdgcn_rcpf(li_l[crow(r, hi)]);
  float* Ow = Ob + (long)(wid * QBLK) * LDO;
#pragma unroll
  for (int r = 0; r < 16; ++r) { int orow = crow(r, hi);
    for (int d0 = 0; d0 < 4; ++d0) Ow[(long)orow * LDO + d0 * 32 + r32] = o[d0][r] * rli[r]; }
#undef SLOAD
#undef SWRITE
#undef SWAIT
#undef RESC
}
}
#define GAS __attribute__((address_space(1)))
#define LAS __attribute__((address_space(3)))
typedef unsigned short bf16;
typedef unsigned v4u __attribute__((ext_vector_type(4)));
typedef unsigned v2u __attribute__((ext_vector_type(2)));
typedef float f32x4 __attribute__((ext_vector_type(4)));
typedef short bf16x8 __attribute__((ext_vector_type(8)));
typedef GAS unsigned gu32;
#define RLX_AGENT __ATOMIC_RELAXED, __HIP_MEMORY_SCOPE_AGENT
#define LDS_WAIT() asm volatile("s_waitcnt lgkmcnt(0)" ::: "memory")
#define VM_WAIT() asm volatile("s_waitcnt vmcnt(0)" ::: "memory")
__device__ __forceinline__ unsigned f2bf(float f) { unsigned u = __builtin_bit_cast(unsigned, f); return (u + 0x7fffu + ((u >> 16) & 1u)) >> 16; }
__device__ __forceinline__ unsigned pk2(float lo, float hi) { return f2bf(lo) | (f2bf(hi) << 16); }
__device__ __forceinline__ float bf_lo(unsigned w) { return __builtin_bit_cast(float, w << 16); }
__device__ __forceinline__ float bf_hi(unsigned w) { return __builtin_bit_cast(float, w & 0xffff0000u); }
__device__ __forceinline__ float wave_sum(float v) {
#pragma unroll
    for (int o = 1; o < 64; o <<= 1) v += __shfl_xor(v, o);
    return v;
}
__device__ __forceinline__ f32x4 mfma16(bf16x8 a, bf16x8 b, f32x4 c) { return __builtin_amdgcn_mfma_f32_16x16x32_bf16(a, b, c, 0, 0, 0); }

__device__ __forceinline__ const float* in_ptr(const LAS unsigned long long* TBL, int i) {
    const unsigned long long v = TBL[i]; const unsigned lo = __builtin_amdgcn_readfirstlane((unsigned)v), hi = __builtin_amdgcn_readfirstlane((unsigned)(v >> 32));
    return (const float*)(const GAS float*)(uintptr_t)(((unsigned long long)hi << 32) | lo);
}
#define INP(i) in_ptr(TBL, i)

#define XB_TMO      128
#define XB_XCNT(j)  (256  + 64 * (j))
#define XB_XSUB(j)  (1280 + 64 * (j))
#define XB_XGEN(j)  (2304 + 64 * (j))
#define XB_TOP      3328
#define XB_TOPGEN   3392
#define XCD_BAR_WORDS 3456
#define XB_SPIN_CAP (1u << 18)

__device__ __forceinline__ unsigned xb_ld(unsigned* p)              { return __hip_atomic_load(p, __ATOMIC_RELAXED, __HIP_MEMORY_SCOPE_AGENT); }
__device__ __forceinline__ unsigned xb_add(unsigned* p, unsigned v) { return __hip_atomic_fetch_add(p, v, __ATOMIC_RELAXED, __HIP_MEMORY_SCOPE_AGENT); }
__device__ __forceinline__ unsigned xb_xcc_id() { return (unsigned)__builtin_amdgcn_s_getreg((3 << 11) | 20) & 0xFu; }
#define XB_SPIN(cond, bar) do { unsigned _sp = 0; while (cond) { __builtin_amdgcn_s_sleep(1); \
    if ((++_sp & 255u) == 0u) { if (xb_ld(&(bar)[XB_TMO])) break; if (_sp > XB_SPIN_CAP) { atomicAdd(&(bar)[XB_TMO], 1u); break; } } } } while (0)

struct XcdBarrier {
    unsigned* bar; unsigned x;
    volatile LAS unsigned* st;
};

__device__ __forceinline__ XcdBarrier xcd_barrier_post(unsigned* bar, volatile LAS unsigned* st) {
    XcdBarrier b; b.bar = bar; b.x = xb_xcc_id(); b.st = st;
    if (threadIdx.x == 0) (void)xb_add(&bar[XB_XCNT(b.x)], 1u);
    return b;
}
__device__ __forceinline__ void xcd_barrier_complete(unsigned* bar, unsigned x, unsigned& nloc, unsigned& nx) {
    const unsigned G = gridDim.x * gridDim.y * gridDim.z;
    unsigned sum, cnt, mine, sp = 0u;
    for (;;) {
        sum = 0u; cnt = 0u; mine = 0u;
#pragma unroll
        for (unsigned j = 0; j < 16; ++j) { const unsigned c = xb_ld(&bar[XB_XCNT(j)]); sum += c; cnt += (c > 0u) ? 1u : 0u; mine = (j == x) ? c : mine; }
        if (sum == G) break;
        __builtin_amdgcn_s_sleep(1);
        if ((++sp & 255u) == 0u) { if (xb_ld(&bar[XB_TMO])) break; if (sp > XB_SPIN_CAP) { atomicAdd(&bar[XB_TMO], 1u); break; } }
    }
    nloc = mine > 0u ? mine : 1u; nx = cnt > 0u ? cnt : 1u;
}

__device__ __forceinline__ void xcd_barrier(const XcdBarrier& b) {
    asm volatile("s_waitcnt vmcnt(0)" ::: "memory");
    __syncthreads();
    if (threadIdx.x == 0) {
        unsigned* bar = b.bar;
        __builtin_amdgcn_s_waitcnt(0);
        unsigned nloc = b.st[0], nx = b.st[1];
        if (nloc == 0u) { xcd_barrier_complete(bar, b.x, nloc, nx); b.st[0] = nloc; b.st[1] = nx; }
        const unsigned old = xb_add(&bar[XB_XSUB(b.x)], 1u);
        const unsigned gen = old / nloc;
        if (old + 1u == (gen + 1u) * nloc) {
            __builtin_amdgcn_fence(__ATOMIC_RELEASE, "agent");
            asm volatile("s_waitcnt vmcnt(0)" ::: "memory");
            const unsigned og = xb_add(&bar[XB_TOP], 1u);
            const unsigned tg = og / nx;
            if (og + 1u == (tg + 1u) * nx) xb_add(&bar[XB_TOPGEN], 1u);
            else XB_SPIN(xb_ld(&bar[XB_TOPGEN]) == tg, bar);
            __builtin_amdgcn_fence(__ATOMIC_ACQUIRE, "agent");
            xb_add(&bar[XB_XGEN(b.x)], 1u);
            asm volatile("s_waitcnt vmcnt(0)" ::: "memory");
        } else {
            XB_SPIN(xb_ld(&bar[XB_XGEN(b.x)]) == gen, bar);
            __builtin_amdgcn_fence(__ATOMIC_ACQUIRE, "agent");
            asm volatile("s_waitcnt vmcnt(0)" ::: "memory");
        }
    }
    __syncthreads();
}
constexpr size_t MiB = 1u << 20;
constexpr size_t WS_CTL = 0, CTL_ZERO_BYTES = 1 * MiB;
constexpr size_t WS_MODP = 1 * MiB;
constexpr size_t WS_MOD = 6 * MiB;
constexpr size_t WS_RCDA = 7 * MiB, WS_RSDA = 8 * MiB;
constexpr size_t WS_RCRT = 9 * MiB, WS_RSRT = 11 * MiB;
constexpr size_t WS_VSS = 13 * MiB;
constexpr size_t WS_WQKV = 16 * MiB;
constexpr size_t WS_WODA = 64 * MiB;
constexpr size_t WS_WSGI = 80 * MiB, WS_WSGO = 96 * MiB;
constexpr size_t WS_WRET = 104 * MiB, WS_WRETO = 152 * MiB;
constexpr size_t WS_WGU = 168 * MiB;
constexpr size_t WS_WD = 344 * MiB;
constexpr size_t WS_X = 432 * MiB;
constexpr size_t WS_HN = 500 * MiB;
constexpr size_t WS_HID = 534 * MiB;
constexpr size_t WS_ACT = 628 * MiB;
constexpr size_t WS_END = 1172 * MiB;
constexpr size_t A34 = 34 * MiB;
constexpr int CW_BAR = 4096;

constexpr int LDS_BYTES = 147456, MISC_OFF = 139264;

struct Args { const float* in[26]; float* out; unsigned char* ws; int ph_lo, ph_hi; };
enum { I_X = 0, I_C, I_CTX, I_CCTX, I_ADAW, I_ADAB, I_NMG, I_NFG, I_WGU, I_WD, I_DAQKV, I_DAO, I_DALAM, I_DASUB, I_SGIN, I_SGVG, I_SGWS, I_SGBS, I_SGOUT,
       I_RQ, I_RK, I_RV, I_RG, I_RO, I_RDEC, I_FNG };

struct TJob { const float* W; bf16* WT; int K, N, kind, row_off; };
__device__ __forceinline__ int dest_row(int kind, int n0) {
    if (kind == 1) {
        if (n0 >= 4096) return n0;
        const int sec = n0 >> 11, r = n0 & 2047, h = r >> 8, m = (r >> 7) & 1, hf = (r >> 6) & 1;
        return sec * 2048 + h * 256 + hf * 128 + m * 64;
    }
    if (kind == 2) {
        if (n0 < FFH) return (n0 >> 7) * 256 + (n0 & 127);
        const int n1 = n0 - FFH; return (n1 >> 7) * 256 + 128 + (n1 & 127);
    }
    return n0;
}
__device__ __forceinline__ void transpose_item(const TJob& J, int item, LAS bf16* scr, int lane) {
    const int nblk = J.N >> 6, kb = item / nblk, nb = item - kb * nblk, k0 = kb << 6, n0 = nb << 6;
    const int drow = J.row_off + dest_row(J.kind, n0);
    const float* src = J.W + (size_t)(k0 + (lane >> 4)) * J.N + n0 + 4 * (lane & 15);
    f32x4 v[16];
#pragma unroll
    for (int i = 0; i < 16; ++i) v[i] = *(const f32x4*)(src + (size_t)(4 * i) * J.N);
#pragma unroll
    for (int i = 0; i < 16; ++i) { const int kk = (lane >> 4) + 4 * i; LAS unsigned* d = (LAS unsigned*)(scr + kk * 66 + 4 * (lane & 15));
        d[0] = pg8::cvt_pk_bf16(v[i].x, v[i].y); d[1] = pg8::cvt_pk_bf16(v[i].z, v[i].w); }
    LDS_WAIT();
    const int c = lane & 7;
#pragma unroll
    for (int j = 0; j < 8; ++j) { const int n = (lane >> 3) + 8 * j; const LAS bf16* s = scr + (8 * c) * 66 + n;
        v4u o; o.x = (unsigned)s[0] | ((unsigned)s[66] << 16); o.y = (unsigned)s[132] | ((unsigned)s[198] << 16);
        o.z = (unsigned)s[264] | ((unsigned)s[330] << 16); o.w = (unsigned)s[396] | ((unsigned)s[462] << 16);
        *(v4u*)(J.WT + (size_t)(drow + n) * J.K + k0 + 8 * c) = o; }
    LDS_WAIT();
}
__device__ __forceinline__ void gemv_item(const float* ada_w, float* MODP, const LAS float* SC, int it, int lane) {
    const int l = it / 384, rem = it - l * 384, ks = rem / 48, nc = rem - ks * 48;
    const float* Wp = ada_w + ((size_t)l * 2048 + ks * 256) * 12288 + nc * 256 + 4 * lane;
    f32x4 a0 = {0.f, 0.f, 0.f, 0.f}, a1 = a0, a2 = a0;
    for (int k = 0; k < 256; k += 16) {
        f32x4 w[16];
#pragma unroll
        for (int i = 0; i < 16; ++i) w[i] = *(const f32x4*)(Wp + (size_t)(k + i) * 12288);
#pragma unroll
        for (int i = 0; i < 16; ++i) { const int kk = ks * 256 + k + i; const float s0 = SC[kk], s1 = SC[2048 + kk], s2 = SC[4096 + kk];
            a0 += w[i] * s0; a1 += w[i] * s1; a2 += w[i] * s2; }
    }
    float* o = MODP + ((size_t)(ks * 4 + l) * 3) * 12288 + nc * 256 + 4 * lane;
    *(f32x4*)o = a0; *(f32x4*)(o + 12288) = a1; *(f32x4*)(o + 24576) = a2;
}

__device__ __forceinline__ void prologue_phase(const LAS unsigned long long* TBL, unsigned char* ws, LAS unsigned char* lds, int tid, int lane, int wave, int gw, int NGW) {
    LAS float* SC = (LAS float*)(lds + 69632);
    for (int idx = tid; idx < 3 * 2048; idx += 512) { const float cv = (idx < 4096) ? INP(I_C)[idx] : INP(I_CCTX)[idx - 4096]; SC[idx] = cv / (1.0f + __expf(-cv)); }
    __syncthreads();
    LAS bf16* scr = (LAS bf16*)(lds + wave * 8448);
    constexpr int N_GEMV = 4 * 8 * 48, N_T = 53248, N_XC = MALL, N_ROPE = SEQ, N_ALL = N_GEMV + N_T + N_XC + N_ROPE;
    for (int it = gw; it < N_ALL; it += NGW) {
        if (it < N_GEMV) { gemv_item(INP(I_ADAW), (float*)(ws + WS_MODP), SC, it, lane); continue; }
        int r = it - N_GEMV;
        if (r < N_T) {
            TJob J; bool found = false;
#define TJ(src_, dst_, K_, N_, kind_, ro_) { const int n_ = ((K_) >> 6) * ((N_) >> 6); if (!found) { if (r < n_) { J.W = (src_); J.WT = (bf16*)(dst_); J.K = (K_); J.N = (N_); J.kind = (kind_); J.row_off = (ro_); found = true; } else r -= n_; } }
            TJ(INP(I_WGU), ws + WS_WGU, 2048, 11264, 2, 0)
            TJ(INP(I_WGU) + (size_t)1 * 2048 * 11264, ws + WS_WGU + 44 * MiB, 2048, 11264, 2, 0)
            TJ(INP(I_WGU) + (size_t)2 * 2048 * 11264, ws + WS_WGU + 88 * MiB, 2048, 11264, 2, 0)
            TJ(INP(I_WGU) + (size_t)3 * 2048 * 11264, ws + WS_WGU + 132 * MiB, 2048, 11264, 2, 0)
            TJ(INP(I_WD), ws + WS_WD, 5632, 2048, 0, 0)
            TJ(INP(I_WD) + (size_t)1 * 5632 * 2048, ws + WS_WD + 22 * MiB, 5632, 2048, 0, 0)
            TJ(INP(I_WD) + (size_t)2 * 5632 * 2048, ws + WS_WD + 44 * MiB, 5632, 2048, 0, 0)
            TJ(INP(I_WD) + (size_t)3 * 5632 * 2048, ws + WS_WD + 66 * MiB, 5632, 2048, 0, 0)
            TJ(INP(I_DAQKV), ws + WS_WQKV, 2048, 6144, 1, 0)
            TJ(INP(I_DAQKV) + (size_t)2048 * 6144, ws + WS_WQKV + 24 * MiB, 2048, 6144, 1, 0)
            TJ(INP(I_DAO), ws + WS_WODA, 2048, 2048, 0, 0)
            TJ(INP(I_DAO) + (size_t)2048 * 2048, ws + WS_WODA + 8 * MiB, 2048, 2048, 0, 0)
            TJ(INP(I_SGIN), ws + WS_WSGI, 2048, 4096, 0, 0)
            TJ(INP(I_SGOUT), ws + WS_WSGO, 2048, 2048, 0, 0)
            TJ(INP(I_RQ), ws + WS_WRET, 2048, 2048, 0, 0)
            TJ(INP(I_RK), ws + WS_WRET, 2048, 2048, 0, 2048)
            TJ(INP(I_RV), ws + WS_WRET, 2048, 4096, 0, 4096)
            TJ(INP(I_RG), ws + WS_WRET, 2048, 4096, 0, 8192)
            TJ(INP(I_RO), ws + WS_WRETO, 4096, 2048, 0, 0)
#undef TJ
            if (found) transpose_item(J, r, scr, lane);
            continue;
        }
        r -= N_T;
        if (r < N_XC) {
            const int b = r / TB, i = r - b * TB;
            const float* src = (i < CTXL) ? INP(I_CTX) + (size_t)(b * CTXL + i) * DM : INP(I_X) + (size_t)(b * SEQ + i - CTXL) * DM;
            float* dst = (float*)(ws + WS_X) + (size_t)r * DM;
#pragma unroll
            for (int j = 0; j < 8; ++j) *(f32x4*)(dst + 256 * j + 4 * lane) = *(const f32x4*)(src + 256 * j + 4 * lane);
            continue;
        }
        r -= N_XC;
        {
            const float rowp = (float)(r >> 6), colp = (float)(r & 63);
            { const int f = lane & 31; const float inv = __builtin_amdgcn_exp2f(-(float)f * (13.287712379549449f / 32.0f)); const float ang = ((lane < 32) ? rowp : colp) * inv;
              const float rev = ang * 0.15915494309189535f, fr = rev - floorf(rev);
              ((float*)(ws + WS_RCDA))[(size_t)r * 64 + lane] = __builtin_amdgcn_cosf(fr); ((float*)(ws + WS_RSDA))[(size_t)r * 64 + lane] = __builtin_amdgcn_sinf(fr); }
#pragma unroll
            for (int q = 0; q < 2; ++q) { const int j = lane + 64 * q, f = j & 63; const float inv = __builtin_amdgcn_exp2f(-(float)f * (13.287712379549449f / 64.0f)); const float ang = ((j < 64) ? rowp : colp) * inv;
              const float rev = ang * 0.15915494309189535f, fr = rev - floorf(rev);
              ((float*)(ws + WS_RCRT))[(size_t)r * 128 + j] = __builtin_amdgcn_cosf(fr); ((float*)(ws + WS_RSRT))[(size_t)r * 128 + j] = __builtin_amdgcn_sinf(fr); }
        }
    }
    __syncthreads();
}
__device__ __forceinline__ void modreduce_phase(const LAS unsigned long long* TBL, unsigned char* ws, int gtid, int gthreads) {
    const float* MODP = (const float*)(ws + WS_MODP); float* MOD = (float*)(ws + WS_MOD);
    for (int idx = gtid; idx < 36864; idx += gthreads) {
        const int e = idx * 4, l = e / 36864, rem = e - l * 36864, j = rem / 12288, n = rem - j * 12288;
        f32x4 s = *(const f32x4*)(INP(I_ADAB) + l * 12288 + n);
#pragma unroll
        for (int ks = 0; ks < 8; ++ks) s += *(const f32x4*)(MODP + ((size_t)(ks * 4 + l) * 3 + j) * 12288 + n);
        *(f32x4*)(MOD + e) = s;
    }
}
__device__ __forceinline__ void norm_phase(LAS unsigned char* lds, int tid, int lane, int gw, int NGW, const float* X, bf16* HN, const float* gain, const float* modl, int sofs, int cofs, bool skipctx) {
    LAS float* A = (LAS float*)lds; LAS float* Bv = A + 3 * 2048;
    for (int idx = tid; idx < 3 * 2048; idx += 512) { const int j = idx >> 11, c = idx & 2047; A[idx] = gain[c] * (1.0f + modl[j * 12288 + cofs + c]); Bv[idx] = modl[j * 12288 + sofs + c]; }
    __syncthreads();
    for (int r = gw; r < MALL; r += NGW) {
        const int b = r / TB, i = r - b * TB, jv = (i < CTXL) ? 2 : b;
        if (skipctx && jv == 2) continue;
        const float* xr = X + (size_t)r * DM + 4 * lane;
        f32x4 v[8]; float ss = 0.f;
#pragma unroll
        for (int j = 0; j < 8; ++j) { v[j] = *(const f32x4*)(xr + 256 * j); ss += (v[j].x * v[j].x + v[j].y * v[j].y) + (v[j].z * v[j].z + v[j].w * v[j].w); }
        ss = wave_sum(ss); const float rstd = 1.0f / sqrtf(ss * (1.0f / 2048.0f) + EPSN);
        const LAS float* Aj = A + jv * 2048 + 4 * lane; const LAS float* Bj = Bv + jv * 2048 + 4 * lane;
        bf16* hr = HN + (size_t)r * DM + 4 * lane;
#pragma unroll
        for (int j = 0; j < 8; ++j) { const f32x4 aa = *(const LAS f32x4*)(Aj + 256 * j), bb = *(const LAS f32x4*)(Bj + 256 * j); const f32x4 h = v[j] * rstd * aa + bb;
            v2u o; o.x = pg8::cvt_pk_bf16(h.x, h.y); o.y = pg8::cvt_pk_bf16(h.z, h.w); *(v2u*)(hr + 256 * j) = o; }
    }
    __syncthreads();
}
__device__ __forceinline__ void final_norm_phase(int lane, int gw, int NGW, const float* X, float* out, const float* gain) {
    for (int r = gw; r < NB * SEQ; r += NGW) {
        const int b = r / SEQ, t = r - b * SEQ; const float* xr = X + (size_t)(b * TB + CTXL + t) * DM + 4 * lane;
        f32x4 v[8]; float ss = 0.f;
#pragma unroll
        for (int j = 0; j < 8; ++j) { v[j] = *(const f32x4*)(xr + 256 * j); ss += (v[j].x * v[j].x + v[j].y * v[j].y) + (v[j].z * v[j].z + v[j].w * v[j].w); }
        ss = wave_sum(ss); const float rstd = 1.0f / sqrtf(ss * (1.0f / 2048.0f) + EPSN);
        float* orow = out + (size_t)r * DM + 4 * lane;
#pragma unroll
        for (int j = 0; j < 8; ++j) *(f32x4*)(orow + 256 * j) = v[j] * rstd * *(const f32x4*)(gain + 256 * j + 4 * lane);
    }
}
__device__ __forceinline__ void da_attn_phase(char* ldsg, int tid, int vcu, int G, const bf16* Q, const bf16* K, const bf16* V, float* OF, bool need_ctx) {
    const int nlat = 1024, total = nlat + (need_ctx ? 64 : 0);
#pragma unroll 1
    for (int u = vcu; u < total; u += G) {
        int head, qb; if (u < nlat) { head = u >> 4; qb = 1 + (u & 15); } else { head = u - nlat; qb = 0; }
        const int b = head >> 5, h = (head >> 2) & 7, m = (head >> 1) & 1, vh = head & 1;
        const size_t rb = (size_t)b * TB;
        const bf16* Qb = Q + (rb + (size_t)qb * 256) * DM + h * 256 + m * 128;
        const bf16* Kh = K + rb * DM + h * 256 + m * 128;
        const bf16* Vh = V + rb * DM + h * 256 + vh * 128;
        float* Ob = OF + (rb + (size_t)qb * 256) * 4096 + (h * 2 + m) * 256 + vh * 128;
        att::attn_dense_body<DM, DM, 4096>(tid, Qb, Kh, Vh, Ob, qb == 0 ? CTXL : TB, ldsg);
        __syncthreads();
    }
}
__device__ __forceinline__ void da_combine_phase(int lane, int gw, int NGW, const float* OF, bf16* DAO, const float* lamv, const float* subg, float lambda_init, bool need_ctx) {
    float sa = lamv[lane] * lamv[128 + lane] + lamv[64 + lane] * lamv[192 + lane], sb = lamv[256 + lane] * lamv[384 + lane] + lamv[320 + lane] * lamv[448 + lane];
    sa = wave_sum(sa); sb = wave_sum(sb);
    const float lam = expf(sa) - expf(sb) + lambda_init, post = 1.0f - lambda_init;
    const f32x4 g4 = *(const f32x4*)(subg + 4 * lane) * post;
    for (int r = gw; r < MALL; r += NGW) {
        const int i = r % TB; if (!need_ctx && i < CTXL) continue;
        const float* orow = OF + (size_t)r * 4096 + 4 * lane; bf16* drow = DAO + (size_t)r * DM + 4 * lane;
#pragma unroll
        for (int h = 0; h < 8; ++h) {
            const f32x4 o1 = *(const f32x4*)(orow + h * 512), o2 = *(const f32x4*)(orow + h * 512 + 256); const f32x4 o = o1 - o2 * lam;
            float ss = (o.x * o.x + o.y * o.y) + (o.z * o.z + o.w * o.w); ss = wave_sum(ss);
            const float rstd = 1.0f / sqrtf(ss * (1.0f / 256.0f) + EPSN); const f32x4 y = o * rstd * g4;
            v2u w; w.x = pg8::cvt_pk_bf16(y.x, y.y); w.y = pg8::cvt_pk_bf16(y.z, y.w); *(v2u*)(drow + h * 256) = w;
        }
    }
}
__device__ __forceinline__ void sg_phase(LAS unsigned char* lds, int tid, int lane, int wave, int vcu, int G, const bf16* U, const bf16* V, const float* VSS,
                                         const float* w_s, const float* b_s, const float* v_gain, bf16* Gout) {
    LAS bf16* vL = (LAS bf16*)lds;
    LAS bf16* wL = (LAS bf16*)(lds + 33280);
    LAS float* rs = (LAS float*)(lds + 68096);
    const int l15 = lane & 15, l4 = lane >> 4;
    for (int unit = vcu; unit < 68 * 16; unit += G) {
        const int ci = unit >> 4, g = unit & 15, row0 = ci * 128;
        __syncthreads();
        if (tid < 128) { const float* p = VSS + (size_t)(row0 + tid) * 32; float s = 0.f;
#pragma unroll
            for (int k = 0; k < 32; ++k) s += p[k];
            rs[tid] = 1.0f / sqrtf(s * (1.0f / 2048.0f) + EPSN); }
        { const int q = tid >> 2, c0 = (tid & 3) * 32; const v4u* src = (const v4u*)(V + (size_t)(row0 + q) * DM + g * 128 + c0); LAS unsigned* d = (LAS unsigned*)(vL + q * 130 + c0);
#pragma unroll
          for (int k = 0; k < 4; ++k) { const v4u x = src[k]; d[4 * k] = x.x; d[4 * k + 1] = x.y; d[4 * k + 2] = x.z; d[4 * k + 3] = x.w; } }
        __syncthreads();
        { const int p = tid >> 2, q0 = (tid & 3) * 32; const float* src = w_s + ((size_t)g * 128 + p) * 128 + q0;
#pragma unroll
          for (int k = 0; k < 4; ++k) { const f32x4 a = *(const f32x4*)(src + 8 * k), b = *(const f32x4*)(src + 8 * k + 4); const LAS float* r8 = rs + q0 + 8 * k;
              const f32x4 ra = *(const LAS f32x4*)r8, rb = *(const LAS f32x4*)(r8 + 4);
              *(LAS v4u*)(wL + p * 136 + q0 + 8 * k) = pg8::pack8(a * ra, b * rb); } }
        __syncthreads();
        bf16x8 aF[4];
#pragma unroll
        for (int kk = 0; kk < 4; ++kk) { const LAS bf16* s = vL + (32 * kk + 8 * l4) * 130 + 16 * wave + l15;
#pragma unroll
            for (int jj = 0; jj < 8; ++jj) aF[kk][jj] = (short)s[jj * 130]; }
        f32x4 acc[8];
#pragma unroll
        for (int pt = 0; pt < 8; ++pt) { acc[pt] = (f32x4){0.f, 0.f, 0.f, 0.f};
#pragma unroll
            for (int kk = 0; kk < 4; ++kk) { const bf16x8 bF = *(const LAS bf16x8*)(wL + (16 * pt + l15) * 136 + 32 * kk + 8 * l4); acc[pt] = mfma16(aF[kk], bF, acc[pt]); } }
        const int col = g * 128 + 16 * wave + 4 * l4; const f32x4 gn = *(const f32x4*)(v_gain + col);
#pragma unroll
        for (int pt = 0; pt < 8; ++pt) { const int p = 16 * pt + l15; const float bs = b_s[g * 128 + p]; const size_t off = (size_t)(row0 + p) * DM + col;
            const v2u uu = *(const v2u*)(U + off); const f32x4 sv = gn * acc[pt] + bs;
            v2u o; o.x = pg8::cvt_pk_bf16(bf_lo(uu.x) * sv.x, bf_hi(uu.x) * sv.y); o.y = pg8::cvt_pk_bf16(bf_lo(uu.y) * sv.z, bf_hi(uu.y) * sv.w); *(v2u*)(Gout + off) = o; }
    }
    __syncthreads();
}
__device__ __forceinline__ void ret_intra_phase(LAS unsigned char* lds, int tid, int lane, int wave, int vcu, int G, const bf16* Q, const bf16* K, const bf16* V, float* OI, const float* decay) {
    LAS bf16* PL = (LAS bf16*)lds;
    LAS bf16* vL = (LAS bf16*)(lds + 34816);
    const int l15 = lane & 15, l4 = lane >> 4;
    for (int unit = vcu; unit < 68 * 8; unit += G) {
        const int bc = unit >> 3, h = unit & 7, row0 = bc * 128;
        const float lgf = -expf(decay[h]) * 1.4426950408889634f, lgb = -expf(decay[8 + h]) * 1.4426950408889634f;
        __syncthreads();
        { bf16x8 qF[8]; const bf16* qp = Q + (size_t)(row0 + 16 * wave + l15) * DM + h * 256 + 8 * l4;
#pragma unroll
          for (int kk = 0; kk < 8; ++kk) qF[kk] = *(const bf16x8*)(qp + 32 * kk);
          const int i = 16 * wave + l15;
#pragma unroll 2
          for (int jt = 0; jt < 8; ++jt) { const bf16* kp = K + (size_t)(row0 + 16 * jt + l15) * DM + h * 256 + 8 * l4; f32x4 acc = {0.f, 0.f, 0.f, 0.f};
#pragma unroll
              for (int kk = 0; kk < 8; ++kk) { const bf16x8 kF = *(const bf16x8*)(kp + 32 * kk); acc = mfma16(kF, qF[kk], acc); }
              float pv[4];
#pragma unroll
              for (int r = 0; r < 4; ++r) { const int j = 16 * jt + 4 * l4 + r; const int dd = i - j;
                  const float w = (dd > 0) ? __builtin_amdgcn_exp2f(lgf * (float)dd) : (dd < 0) ? __builtin_amdgcn_exp2f(lgb * (float)(-dd)) : 2.0f; pv[r] = acc[r] * w; }
              v2u o; o.x = pg8::cvt_pk_bf16(pv[0], pv[1]); o.y = pg8::cvt_pk_bf16(pv[2], pv[3]); *(LAS v2u*)(PL + i * 136 + 16 * jt + 4 * l4) = o; } }
        for (int ec = 0; ec < 4; ++ec) {
            __syncthreads();
            { const int q = tid >> 2, c0 = (tid & 3) * 32; const v4u* src = (const v4u*)(V + (size_t)(row0 + q) * 4096 + h * 512 + ec * 128 + c0); LAS unsigned* d = (LAS unsigned*)(vL + q * 130 + c0);
#pragma unroll
              for (int k = 0; k < 4; ++k) { const v4u x = src[k]; d[4 * k] = x.x; d[4 * k + 1] = x.y; d[4 * k + 2] = x.z; d[4 * k + 3] = x.w; } }
            __syncthreads();
            bf16x8 aF[4];
#pragma unroll
            for (int kk = 0; kk < 4; ++kk) { const LAS bf16* s = vL + (32 * kk + 8 * l4) * 130 + 16 * wave + l15;
#pragma unroll
                for (int jj = 0; jj < 8; ++jj) aF[kk][jj] = (short)s[jj * 130]; }
#pragma unroll
            for (int it = 0; it < 8; ++it) { f32x4 acc = {0.f, 0.f, 0.f, 0.f};
#pragma unroll
                for (int kk = 0; kk < 4; ++kk) { const bf16x8 bF = *(const LAS bf16x8*)(PL + (16 * it + l15) * 136 + 32 * kk + 8 * l4); acc = mfma16(aF[kk], bF, acc); }
                *(f32x4*)(OI + (size_t)(row0 + 16 * it + l15) * 4096 + h * 512 + ec * 128 + 16 * wave + 4 * l4) = acc; }
        }
    }
    __syncthreads();
}
__device__ __forceinline__ void ret_scan_phase(LAS unsigned char* lds, int tid, int lane, int wave, int vcu, int G, const bf16* Q, const bf16* K, const bf16* V, float* ORr, const float* decay) {
    LAS bf16* KL = (LAS bf16*)lds;
    LAS bf16* VL = (LAS bf16*)(lds + 67584);
    LAS bf16* SB = (LAS bf16*)(lds + 67584 + 8704);
    const int l15 = lane & 15, l4 = lane >> 4;
    for (int unit = vcu; unit < 256; unit += G) {
        const int b = unit >> 7, h = (unit >> 4) & 7, s = unit & 15;
#pragma unroll 1
        for (int dir = 0; dir < 2; ++dir) {
            const float lg2 = -expf(decay[dir * 8 + h]) * 1.4426950408889634f; const float gC = __builtin_amdgcn_exp2f(lg2 * 128.0f);
            f32x4 Sr[2][2];
#pragma unroll
            for (int a = 0; a < 2; ++a)
#pragma unroll
                for (int e = 0; e < 2; ++e) Sr[a][e] = (f32x4){0.f, 0.f, 0.f, 0.f};
#pragma unroll 1
            for (int step = 0; step < 34; ++step) {
                const int c = (dir == 0) ? step : (step < 2 ? 1 - step : 35 - step);
                const size_t row0 = (size_t)(b * 34 + c) * 128;
                __syncthreads();
#pragma unroll
                for (int a = 0; a < 2; ++a)
#pragma unroll
                    for (int e = 0; e < 2; ++e) { v2u o; o.x = pg8::cvt_pk_bf16(Sr[a][e][0], Sr[a][e][1]); o.y = pg8::cvt_pk_bf16(Sr[a][e][2], Sr[a][e][3]);
                        *(LAS v2u*)(SB + (16 * e + l15) * 264 + 16 * (2 * wave + a) + 4 * l4) = o; }
                { const int j = tid >> 2, c0 = (tid & 3) * 64; const v4u* src = (const v4u*)(K + (row0 + j) * DM + h * 256 + c0); LAS v4u* d = (LAS v4u*)(KL + j * 264 + c0);
#pragma unroll
                  for (int k = 0; k < 8; ++k) d[k] = src[k];
                  const float z = __builtin_amdgcn_exp2f(lg2 * (float)((dir == 0) ? (127 - j) : j));
                  const v4u x = *(const v4u*)(V + (row0 + j) * 4096 + h * 512 + s * 32 + (tid & 3) * 8); LAS unsigned* dv = (LAS unsigned*)(VL + j * 34 + (tid & 3) * 8);
                  dv[0] = pg8::cvt_pk_bf16(bf_lo(x.x) * z, bf_hi(x.x) * z); dv[1] = pg8::cvt_pk_bf16(bf_lo(x.y) * z, bf_hi(x.y) * z);
                  dv[2] = pg8::cvt_pk_bf16(bf_lo(x.z) * z, bf_hi(x.z) * z); dv[3] = pg8::cvt_pk_bf16(bf_lo(x.w) * z, bf_hi(x.w) * z); }
                __syncthreads();
                { bf16x8 qF[8]; const bf16* qp = Q + (row0 + 16 * wave + l15) * DM + h * 256 + 8 * l4;
#pragma unroll
                  for (int kk = 0; kk < 8; ++kk) qF[kk] = *(const bf16x8*)(qp + 32 * kk);
                  const int i = 16 * wave + l15; const float xi = __builtin_amdgcn_exp2f(lg2 * (float)((dir == 0) ? (i + 1) : (128 - i)));
#pragma unroll
                  for (int et = 0; et < 2; ++et) { f32x4 acc = {0.f, 0.f, 0.f, 0.f};
#pragma unroll
                      for (int kk = 0; kk < 8; ++kk) { const bf16x8 sF = *(const LAS bf16x8*)(SB + (16 * et + l15) * 264 + 32 * kk + 8 * l4); acc = mfma16(sF, qF[kk], acc); }
                      f32x4* op = (f32x4*)(ORr + (row0 + i) * 4096 + h * 512 + s * 32 + 16 * et + 4 * l4);
                      if (dir == 0) *op = acc * xi; else *op = *op + acc * xi; } }
#pragma unroll
                for (int a = 0; a < 2; ++a)
#pragma unroll
                    for (int e = 0; e < 2; ++e) Sr[a][e] = Sr[a][e] * gC;
#pragma unroll
                for (int kk = 0; kk < 4; ++kk) { bf16x8 kF[2], vF[2];
#pragma unroll
                    for (int a = 0; a < 2; ++a) { const LAS bf16* sp = KL + (32 * kk + 8 * l4) * 264 + 16 * (2 * wave + a) + l15;
#pragma unroll
                        for (int jj = 0; jj < 8; ++jj) kF[a][jj] = (short)sp[jj * 264]; }
#pragma unroll
                    for (int e = 0; e < 2; ++e) { const LAS bf16* sp = VL + (32 * kk + 8 * l4) * 34 + 16 * e + l15;
#pragma unroll
                        for (int jj = 0; jj < 8; ++jj) vF[e][jj] = (short)sp[jj * 34]; }
#pragma unroll
                    for (int a = 0; a < 2; ++a)
#pragma unroll
                        for (int e = 0; e < 2; ++e) Sr[a][e] = mfma16(kF[a], vF[e], Sr[a][e]); }
            }
        }
    }
    __syncthreads();
}
__device__ __forceinline__ void ret_gate_phase(int lane, int gw, int NGW, const float* OI, const float* ORr, const bf16* Gt, bf16* RO) {
    for (int r = gw; r < MALL; r += NGW) {
#pragma unroll
        for (int h = 0; h < 8; ++h) { const size_t off = (size_t)r * 4096 + h * 512 + 4 * lane;
            const f32x4 o0 = *(const f32x4*)(OI + off) + *(const f32x4*)(ORr + off), o1 = *(const f32x4*)(OI + off + 256) + *(const f32x4*)(ORr + off + 256);
            float ss = (o0.x * o0.x + o0.y * o0.y) + (o0.z * o0.z + o0.w * o0.w) + (o1.x * o1.x + o1.y * o1.y) + (o1.z * o1.z + o1.w * o1.w); ss = wave_sum(ss);
            const float rstd = 1.0f / sqrtf(ss * (1.0f / 512.0f) + EPSN);
            const v2u g0 = *(const v2u*)(Gt + off), g1 = *(const v2u*)(Gt + off + 256);
            v2u w0, w1; w0.x = pg8::cvt_pk_bf16(bf_lo(g0.x) * o0.x * rstd, bf_hi(g0.x) * o0.y * rstd); w0.y = pg8::cvt_pk_bf16(bf_lo(g0.y) * o0.z * rstd, bf_hi(g0.y) * o0.w * rstd);
            w1.x = pg8::cvt_pk_bf16(bf_lo(g1.x) * o1.x * rstd, bf_hi(g1.x) * o1.y * rstd); w1.y = pg8::cvt_pk_bf16(bf_lo(g1.y) * o1.z * rstd, bf_hi(g1.y) * o1.w * rstd);
            *(v2u*)(RO + off) = w0; *(v2u*)(RO + off + 256) = w1; }
    }
}
template <class Epi> __device__ __forceinline__ void run_gemm(int tid, LAS unsigned char* lds, int G, const bf16* A, const bf16* Bt, int N, int K, bool skipctx, const Epi& E) {
    pg8::Gemm g{A, Bt, MALL, N, K}; pg8::Order S; S.init(skipctx ? 32 : 34, N / 256, G, (int)blockIdx.x, skipctx ? 1 : 0);
    pg8::gemm_phase<Epi, pg8::Order, true, true>(tid, lds, g, S, E);
}
constexpr int N_PHASES = 2 + 8 * DEPTH + 1;

__global__ void __launch_bounds__(512, 2) fwd_kernel(Args args) {
    extern __shared__ __attribute__((aligned(16))) unsigned char lds_raw[];
    LAS unsigned char* lds = (LAS unsigned char*)lds_raw;
    volatile LAS unsigned* MISC = (volatile LAS unsigned*)(lds + MISC_OFF);
    const int tid0 = threadIdx.x;
    const int G = gridDim.x; const int bx = blockIdx.x; const int vcu = (G % 8 == 0) ? (bx % 8) * (G / 8) + bx / 8 : bx;
    const int NGW = G * 8;
    unsigned char* ws0 = args.ws;
    if (tid0 < 32) MISC[tid0] = 0u;
    LAS unsigned long long* TBL = (LAS unsigned long long*)(lds + MISC_OFF + 256);
    if (tid0 == 0) {
#define TB_ST(i) TBL[i] = (unsigned long long)(uintptr_t)args.in[i];
        TB_ST(0) TB_ST(1) TB_ST(2) TB_ST(3) TB_ST(4) TB_ST(5) TB_ST(6) TB_ST(7) TB_ST(8) TB_ST(9) TB_ST(10) TB_ST(11) TB_ST(12) TB_ST(13) TB_ST(14) TB_ST(15) TB_ST(16) TB_ST(17) TB_ST(18) TB_ST(19) TB_ST(20) TB_ST(21) TB_ST(22) TB_ST(23) TB_ST(24) TB_ST(25)
#undef TB_ST
    }
    __syncthreads();
    const int lo = args.ph_lo, hi = args.ph_hi;
    XcdBarrier bar; bar.bar = (unsigned*)(ws0 + WS_CTL) + CW_BAR; bar.x = 0; bar.st = nullptr;
    if (hi - lo > 1) bar = xcd_barrier_post((unsigned*)(ws0 + WS_CTL) + CW_BAR, MISC + 8);
#ifndef PHMASK
#define PHMASK 0xFFFFFFFFu
#endif
#define PH_BEGIN(k, kb) if (((PHMASK >> (kb)) & 1u) && lo <= (k) && (k) < hi) { int tid = tid0; asm volatile("" : "+v"(tid)); const int lane = tid & 63, wave = __builtin_amdgcn_readfirstlane(tid >> 6); const int gw = vcu * 8 + wave; \
    size_t zo = 0; asm volatile("" : "+s"(zo)); unsigned char* ws = ws0 + zo; float* X = (float*)(ws + WS_X); bf16* HN = (bf16*)(ws + WS_HN); bf16* HID = (bf16*)(ws + WS_HID); const float* MOD = (const float*)(ws + WS_MOD); unsigned char* act = ws + WS_ACT; const float* modl = MOD + (size_t)layer * 3 * 12288; (void)X; (void)HN; (void)HID; (void)act; (void)modl; (void)lane; (void)gw;
#define PH_END(k)   if ((k) + 1 < hi) xcd_barrier(bar); }

    int layer = 0;

    PH_BEGIN(0, 0) prologue_phase(TBL, ws, lds, tid, lane, wave, gw, NGW); PH_END(0)
    PH_BEGIN(1, 1) modreduce_phase(TBL, ws, vcu * 512 + tid, G * 512); PH_END(1)

#pragma unroll 1
    for (layer = 0; layer < DEPTH; ++layer) {
        const int kind = layer % 3, jj = layer / 3, pb = 2 + 8 * layer; const bool last = (layer == DEPTH - 1);
        PH_BEGIN(pb + 0, 2) norm_phase(lds, tid, lane, gw, NGW, X, HN, INP(I_NMG) + layer * DM, modl, 0, 2048, false); PH_END(pb + 0)
        size_t mixAoff, mixWoff; int mixK;
        if (kind == 0) {
#define DA_PTRS bf16 *Qd = (bf16*)act, *Kd = (bf16*)(act + A34), *Vd = (bf16*)(act + 2 * A34); float* OF = (float*)(act + 3 * A34); bf16* DAO = (bf16*)(act + 7 * A34); (void)Qd; (void)Kd; (void)Vd; (void)OF; (void)DAO;
            PH_BEGIN(pb + 1, 3) { DA_PTRS pg8::EpiQkvDa E{Qd, Kd, Vd, (const float*)(ws + WS_RCDA), (const float*)(ws + WS_RSDA)};
                run_gemm(tid, lds, G, HN, (const bf16*)(ws + WS_WQKV + (size_t)jj * 24 * MiB), 6144, 2048, false, E); } PH_END(pb + 1)
            PH_BEGIN(pb + 2, 4) { DA_PTRS da_attn_phase((char*)lds_raw, tid, vcu, G, Qd, Kd, Vd, OF, !last); } PH_END(pb + 2)
            PH_BEGIN(pb + 3, 5) { DA_PTRS da_combine_phase(lane, gw, NGW, OF, DAO, INP(I_DALAM) + jj * 512, INP(I_DASUB) + jj * 256, 0.8f - 0.6f * expf(-0.3f * (float)layer), !last); } PH_END(pb + 3)
            mixAoff = WS_ACT + 7 * A34; mixWoff = WS_WODA + (size_t)jj * 8 * MiB; mixK = 2048;
        } else if (kind == 1) {
#define SG_PTRS bf16 *Ud = (bf16*)act, *Vd = (bf16*)(act + A34), *Gd = (bf16*)(act + 2 * A34); float* VSS = (float*)(ws + WS_VSS); (void)Ud; (void)Vd; (void)Gd; (void)VSS;
            PH_BEGIN(pb + 1, 6) { SG_PTRS pg8::EpiSgIn E{Ud, Vd, VSS}; run_gemm(tid, lds, G, HN, (const bf16*)(ws + WS_WSGI), 4096, 2048, false, E); } PH_END(pb + 1)
            PH_BEGIN(pb + 2, 7) { SG_PTRS sg_phase(lds, tid, lane, wave, vcu, G, Ud, Vd, VSS, INP(I_SGWS), INP(I_SGBS), INP(I_SGVG), Gd); } PH_END(pb + 2)
            mixAoff = WS_ACT + 2 * A34; mixWoff = WS_WSGO; mixK = 2048;
        } else {
#define RT_PTRS bf16 *Qd = (bf16*)act, *Kd = (bf16*)(act + A34), *Vd = (bf16*)(act + 2 * A34), *Gt = (bf16*)(act + 4 * A34); float *OI = (float*)(act + 6 * A34), *ORr = (float*)(act + 10 * A34); bf16* RO = (bf16*)(act + 14 * A34); (void)Qd; (void)Kd; (void)Vd; (void)Gt; (void)OI; (void)ORr; (void)RO;
            PH_BEGIN(pb + 1, 8) { RT_PTRS pg8::EpiRet E{Qd, Kd, Vd, Gt, (const float*)(ws + WS_RCRT), (const float*)(ws + WS_RSRT)}; run_gemm(tid, lds, G, HN, (const bf16*)(ws + WS_WRET), 12288, 2048, false, E); } PH_END(pb + 1)
            PH_BEGIN(pb + 2, 9) { RT_PTRS ret_scan_phase(lds, tid, lane, wave, vcu, G, Qd, Kd, Vd, ORr, INP(I_RDEC));
                             ret_intra_phase(lds, tid, lane, wave, vcu, G, Qd, Kd, Vd, OI, INP(I_RDEC)); } PH_END(pb + 2)
            PH_BEGIN(pb + 3, 10) { RT_PTRS ret_gate_phase(lane, gw, NGW, OI, ORr, Gt, RO); } PH_END(pb + 3)
            mixAoff = WS_ACT + 14 * A34; mixWoff = WS_WRETO; mixK = 4096;
        }
        PH_BEGIN(pb + 4, 11) { pg8::EpiRes E{X, modl, 2 * 2048}; run_gemm(tid, lds, G, (const bf16*)(ws + mixAoff), (const bf16*)(ws + mixWoff), 2048, mixK, last, E); } PH_END(pb + 4)
        PH_BEGIN(pb + 5, 2) norm_phase(lds, tid, lane, gw, NGW, X, HN, INP(I_NFG) + layer * DM, modl, 3 * 2048, 4 * 2048, last); PH_END(pb + 5)
        PH_BEGIN(pb + 6, 12) { pg8::EpiSwiglu E{HID}; run_gemm(tid, lds, G, HN, (const bf16*)(ws + WS_WGU + (size_t)layer * 44 * MiB), 11264, 2048, last, E); } PH_END(pb + 6)
        PH_BEGIN(pb + 7, 13) { pg8::EpiRes E{X, modl, 5 * 2048}; run_gemm(tid, lds, G, HID, (const bf16*)(ws + WS_WD + (size_t)layer * 22 * MiB), 2048, FFH, last, E); } PH_END(pb + 7)
    }
    PH_BEGIN(N_PHASES - 1, 14) final_norm_phase(lane, gw, NGW, X, args.out, INP(I_FNG)); PH_END(N_PHASES - 1)
#undef PH_BEGIN
#undef PH_END
}

#ifndef ONE_LAUNCH
#define ONE_LAUNCH 1
#endif
extern "C" void kernel_launch(void* const* d_in, const int* in_sizes, int n_in, void* d_out, int out_size, void* d_ws, size_t ws_size, hipStream_t stream) {
    static int grid = 0;
    if (grid == 0) {
        if (n_in != 26 || out_size != NB * SEQ * DM || ws_size < WS_END) { fprintf(stderr, "kernel_launch: unexpected shapes (n_in %d, out %d, ws %zu < %zu)\n", n_in, out_size, ws_size, (size_t)WS_END); grid = -1; return; }
        int dev = 0, cus = 0;
        if (hipGetDevice(&dev) != hipSuccess || hipDeviceGetAttribute(&cus, hipDeviceAttributeMultiprocessorCount, dev) != hipSuccess) { grid = -1; return; }
        if (hipFuncSetAttribute((const void*)fwd_kernel, hipFuncAttributeMaxDynamicSharedMemorySize, LDS_BYTES) != hipSuccess) { fprintf(stderr, "kernel_launch: hipFuncSetAttribute failed\n"); grid = -1; return; }
        grid = cus;
    }
    if (grid < 0) return;
    (void)hipMemsetAsync((char*)d_ws + WS_CTL, 0, CTL_ZERO_BYTES, stream);
    Args a{};
    for (int i = 0; i < 26; ++i) a.in[i] = (const float*)d_in[i];
    a.out = (float*)d_out; a.ws = (unsigned char*)d_ws;
#if ONE_LAUNCH
    a.ph_lo = 0; a.ph_hi = N_PHASES;
    hipLaunchKernelGGL(fwd_kernel, dim3(grid), dim3(512), LDS_BYTES, stream, a);
#else
    for (int p = 0; p < N_PHASES; ++p) {
        if (p == 2 + 8 * 1 + 3) continue;
        a.ph_lo = p; a.ph_hi = p + 1;
        hipLaunchKernelGGL(fwd_kernel, dim3(grid), dim3(512), LDS_BYTES, stream, a);
    }
#endif
}
```

```cpp
#include <hip/hip_runtime.h>
#include <cstdio>
#include <cstdint>

constexpr int DM = 2048, NB = 2, SEQ = 4096, CTXL = 256, TB = SEQ + CTXL  , MALL = NB * TB  ;
constexpr int FFH = 5632, DEPTH = 4;
constexpr float EPSN = 1e-6f;

namespace pg8 {
#define PG8_LAS __attribute__((address_space(3)))
typedef unsigned short bf16_t;
typedef short bf16x8 __attribute__((ext_vector_type(8)));
typedef float f32x4 __attribute__((ext_vector_type(4)));
typedef unsigned u32x4 __attribute__((ext_vector_type(4)));
constexpr int BM = 256, BK = 64, HALF = 128, HTB = HALF * BK * 2  , STAGE_BYTES = 8 * HTB, NXCD = 8, WGM = 8;

__host__ __device__ __forceinline__ int lds_byte(int r, int c) { const int st = (r >> 4) * 2 + (c >> 5), rr = r & 15, cc = c & 31, ob = rr * 64 + cc * 2; return st * 1024 + (ob ^ (((ob >> 9) & 1) << 5)); }
__host__ __device__ __forceinline__ void stage_rc(int b, int& R, int& C) { const int st = b / 1024, sb = b % 1024, swz = sb ^ (((sb >> 9) & 1) << 5); R = (st >> 1) * 16 + swz / 64; C = (st & 1) * 32 + (swz % 64) / 2; }
__host__ __device__ __forceinline__ int perm32(int rho) { const int n = rho >> 4, i = rho & 15; return 8 * (i >> 2) + 4 * n + (i & 3); }

struct Unit { int pm, pn, k0, nt, slab; };
struct Gemm { const bf16_t* A; const bf16_t* Bt; int M, N, K; };


struct Order {
    int nM, nN, nwg, G, c, skip, ntk, S, snt;
    __device__ __forceinline__ void init(int nM_, int nN_, int G_, int c_, int skip_, int ntk_, int S_, int snt_) { nM = nM_; nN = nN_; nwg = nM * nN; G = G_; c = c_; skip = skip_; ntk = ntk_; S = S_; snt = snt_; }
    __device__ __forceinline__ bool next(int i, Unit& u) const {
        const long L = (long)i * G + c;
        if (L >= nwg) {
            const int s = (int)(L - nwg); if (s >= 2 * nN * S) return false;
            const int cu = s / S, part = s - cu * S; u.pm = (cu >= nN) ? 17 : 0; u.pn = (cu >= nN) ? cu - nN : cu; u.k0 = part * snt; u.nt = snt; u.slab = part; return true;
        }
        int wgid = (int)L; { const int q = nwg / NXCD, r = nwg % NXCD, xcd = wgid % NXCD, off = wgid / NXCD; wgid = (xcd < r ? xcd * (q + 1) : r * (q + 1) + (xcd - r) * q) + off; }
        const int nig = WGM * nN, gid = wgid / nig, fm = gid * WGM, gsz = (nM - fm) < WGM ? (nM - fm) : WGM;
        int pm = fm + ((wgid % nig) % gsz); u.pn = (wgid % nig) / gsz;
        if (skip) pm = pm + 1 + (pm >= 16 ? 1 : 0);
        u.pm = pm; u.k0 = 0; u.nt = ntk; u.slab = -1; return true;
    }
    __device__ __forceinline__ void a_ready(const Unit&) const {}
    __device__ __forceinline__ void done(const Unit&) const {}
};

typedef float f32x2_t __attribute__((ext_vector_type(2))); typedef __bf16 bf16x2_t __attribute__((ext_vector_type(2)));
__device__ __forceinline__ unsigned cvt_pk_bf16(float lo, float hi) { f32x2_t v = {lo, hi}; bf16x2_t b = __builtin_convertvector(v, bf16x2_t); return __builtin_bit_cast(unsigned, b); }
typedef float f32x2 __attribute__((ext_vector_type(2)));
__device__ __forceinline__ f32x2 gelu_pk(f32x2 v) {
    const f32x2 av = __builtin_elementwise_abs(v), d = av * 0.2316418882f + 1.0f;
    f32x2 t; t.x = __builtin_amdgcn_rcpf(d.x); t.y = __builtin_amdgcn_rcpf(d.y);
    f32x2 q = t * 0.5307027145f + (-0.7265760135f); q = q * t + 0.7107068705f; q = q * t + (-0.142248368f); q = q * t + 0.127414796f; q = q * t;
    const f32x2 s = (v * v) * (-0.72134752044f);
    f32x2 e; e.x = __builtin_amdgcn_exp2f(s.x); e.y = __builtin_amdgcn_exp2f(s.y);
    const f32x2 m = v * (q * e), r = v - m;
    f32x2 o; o.x = v.x < 0.f ? m.x : r.x; o.y = v.y < 0.f ? m.y : r.y; return o;
}
__device__ __forceinline__ f32x4 gelu4(f32x4 v) { const f32x2 a = gelu_pk((f32x2){v[0], v[1]}), b = gelu_pk((f32x2){v[2], v[3]}); return (f32x4){a.x, a.y, b.x, b.y}; }
__device__ __forceinline__ float silu1(float x) { return x * __builtin_amdgcn_rcpf(1.0f + __builtin_amdgcn_exp2f(-1.4426950408889634f * x)); }
__device__ __forceinline__ f32x4 silu4(f32x4 v) { return (f32x4){silu1(v[0]), silu1(v[1]), silu1(v[2]), silu1(v[3])}; }
__device__ __forceinline__ u32x4 pack8(f32x4 a, f32x4 b) { u32x4 w; w.x = cvt_pk_bf16(a[0], a[1]); w.y = cvt_pk_bf16(a[2], a[3]); w.z = cvt_pk_bf16(b[0], b[1]); w.w = cvt_pk_bf16(b[2], b[3]); return w; }
__device__ __forceinline__ int cvec_of_panel(int pm) { return (pm % 17 == 0) ? 2 : pm / 17; }

struct EpiRes {
    static constexpr bool PERM = false, AFTER_DRAIN = false;
    float* X; const float* modl; int gofs; float* SL; float pscale;
    __device__ __forceinline__ void operator()(const f32x4 (&acc)[2][2][4][2], const Unit& u, int wr, int wc, int fr, int fq) const {
        const int col0 = u.pn * BM + wc * 32 + 4 * fq;
        if (u.slab >= 0) {
            const int crow0 = (u.pm == 17 ? 256 : 0) + wr * 64 + fr; float* base = SL + ((size_t)u.slab * 512 + crow0) * DM + col0;
#pragma unroll
            for (int ai = 0; ai < 2; ++ai)
#pragma unroll
                for (int m = 0; m < 4; ++m) { float* rowp = base + (size_t)(ai * HALF + m * 16) * DM;
#pragma unroll
                    for (int bj = 0; bj < 2; ++bj)
#pragma unroll
                        for (int n = 0; n < 2; ++n) *(f32x4*)(rowp + bj * HALF + n * 16) = acc[ai][bj][m][n]; }
            return;
        }
        const float* gate = modl + cvec_of_panel(u.pm) * 12288 + gofs;
        const int row0 = u.pm * BM + wr * 64 + fr;
        f32x4 gv[2][2];
#pragma unroll
        for (int bj = 0; bj < 2; ++bj)
#pragma unroll
            for (int n = 0; n < 2; ++n) gv[bj][n] = *(const f32x4*)(gate + col0 + bj * HALF + n * 16) * pscale;
#pragma unroll
        for (int ai = 0; ai < 2; ++ai)
#pragma unroll
            for (int m = 0; m < 4; ++m) { float* rowp = X + (size_t)(row0 + ai * HALF + m * 16) * DM + col0;
#pragma unroll
                for (int bj = 0; bj < 2; ++bj)
#pragma unroll
                    for (int n = 0; n < 2; ++n) { f32x4* p = (f32x4*)(rowp + bj * HALF + n * 16); *p = *p + gv[bj][n] * acc[ai][bj][m][n]; } }
    }
};
struct EpiSwiglu {
    static constexpr bool PERM = true, AFTER_DRAIN = false;
    bf16_t* H;
    __device__ __forceinline__ void operator()(const f32x4 (&acc)[2][2][4][2], const Unit& u, int wr, int wc, int fr, int fq) const {
        const int row0 = u.pm * BM + wr * 64 + fr, col0 = u.pn * HALF + wc * 32 + 8 * fq;
#pragma unroll
        for (int ai = 0; ai < 2; ++ai)
#pragma unroll
            for (int m = 0; m < 4; ++m) { bf16_t* rowp = H + (size_t)(row0 + ai * HALF + m * 16) * FFH + col0;
                const f32x4 o0 = silu4(acc[ai][0][m][0]) * acc[ai][1][m][0], o1 = silu4(acc[ai][0][m][1]) * acc[ai][1][m][1];
                *(u32x4*)rowp = pack8(o0, o1); }
    }
};
struct EpiQkvDa {
    static constexpr bool PERM = true, AFTER_DRAIN = false;
    bf16_t *Q, *K, *V; const float *rc, *rs;
    __device__ __forceinline__ void operator()(const f32x4 (&acc)[2][2][4][2], const Unit& u, int wr, int wc, int fr, int fq) const {
        const int row0 = u.pm * BM + wr * 64 + fr;
        if (u.pn >= 16) {
            const int col0 = (u.pn - 16) * BM + wc * 32 + 8 * fq;
#pragma unroll
            for (int ai = 0; ai < 2; ++ai)
#pragma unroll
                for (int m = 0; m < 4; ++m) { bf16_t* rowp = V + (size_t)(row0 + ai * HALF + m * 16) * DM + col0;
#pragma unroll
                    for (int bj = 0; bj < 2; ++bj) *(u32x4*)(rowp + bj * HALF) = pack8(acc[ai][bj][m][0], acc[ai][bj][m][1]); }
        } else {
            bf16_t* dst = (u.pn < 8) ? Q : K; const int h = u.pn & 7;
            const bool lat = (u.pm % 17) != 0; const int tb = (u.pm / 17) * TB + CTXL;
            const int mp = wc >> 1, dd0 = (wc & 1) * 32 + 8 * fq, colb = h * 256 + mp * 128 + dd0;
#pragma unroll
            for (int ai = 0; ai < 2; ++ai)
#pragma unroll
                for (int m = 0; m < 4; ++m) { const int row = row0 + ai * HALF + m * 16;
                    f32x4 o1a = acc[ai][0][m][0], o1b = acc[ai][0][m][1], o2a = acc[ai][1][m][0], o2b = acc[ai][1][m][1];
                    if (lat) { const size_t to = (size_t)(row - tb) * 64 + dd0;
                        const f32x4 ca = *(const f32x4*)(rc + to), cb = *(const f32x4*)(rc + to + 4), sa = *(const f32x4*)(rs + to), sb = *(const f32x4*)(rs + to + 4);
                        const f32x4 x1a = o1a, x1b = o1b, x2a = o2a, x2b = o2b;
                        o1a = x1a * ca - x2a * sa; o2a = x1a * sa + x2a * ca; o1b = x1b * cb - x2b * sb; o2b = x1b * sb + x2b * cb; }
                    bf16_t* rowp = dst + (size_t)row * DM + colb;
                    *(u32x4*)rowp = pack8(o1a, o1b); *(u32x4*)(rowp + 64) = pack8(o2a, o2b); }
        }
    }
};
struct EpiSgIn {
    static constexpr bool PERM = true, AFTER_DRAIN = false;
    bf16_t *U, *V; float* VSS;
    __device__ __forceinline__ void operator()(const f32x4 (&acc)[2][2][4][2], const Unit& u, int wr, int wc, int fr, int fq) const {
        const int row0 = u.pm * BM + wr * 64 + fr; const bool isv = u.pn >= 8;
        bf16_t* dst = isv ? V : U; const int col0 = (u.pn & 7) * BM + wc * 32 + 8 * fq;
#pragma unroll
        for (int ai = 0; ai < 2; ++ai)
#pragma unroll
            for (int m = 0; m < 4; ++m) { const int row = row0 + ai * HALF + m * 16; bf16_t* rowp = dst + (size_t)row * DM + col0; float ss = 0.f;
#pragma unroll
                for (int bj = 0; bj < 2; ++bj) { const f32x4 v0 = gelu4(acc[ai][bj][m][0]), v1 = gelu4(acc[ai][bj][m][1]);
                    ss += (v0[0] * v0[0] + v0[1] * v0[1]) + (v0[2] * v0[2] + v0[3] * v0[3]) + (v1[0] * v1[0] + v1[1] * v1[1]) + (v1[2] * v1[2] + v1[3] * v1[3]);
                    *(u32x4*)(rowp + bj * HALF) = pack8(v0, v1); }
                if (isv) { ss += __shfl_xor(ss, 16); ss += __shfl_xor(ss, 32); if (fq == 0) VSS[(size_t)row * 32 + (u.pn - 8) * 4 + wc] = ss; } }
    }
};
struct EpiRet {
    static constexpr bool PERM = true, AFTER_DRAIN = false;
    bf16_t *Q, *K, *V, *Gt; const float *rc, *rs;
    __device__ __forceinline__ void operator()(const f32x4 (&acc)[2][2][4][2], const Unit& u, int wr, int wc, int fr, int fq) const {
        const int row0 = u.pm * BM + wr * 64 + fr;
        if (u.pn >= 16) {
            const bool isg = u.pn >= 32; bf16_t* dst = isg ? Gt : V; const int col0 = ((u.pn - 16) & 15) * BM + wc * 32 + 8 * fq;
#pragma unroll
            for (int ai = 0; ai < 2; ++ai)
#pragma unroll
                for (int m = 0; m < 4; ++m) { bf16_t* rowp = dst + (size_t)(row0 + ai * HALF + m * 16) * 4096 + col0;
#pragma unroll
                    for (int bj = 0; bj < 2; ++bj) { f32x4 v0 = acc[ai][bj][m][0], v1 = acc[ai][bj][m][1]; if (isg) { v0 = silu4(v0); v1 = silu4(v1); }
                        *(u32x4*)(rowp + bj * HALF) = pack8(v0, v1); } }
        } else {
            const bool isk = u.pn >= 8; bf16_t* dst = isk ? K : Q; const int h = u.pn & 7; const float sc = isk ? 0.0625f : 1.0f;
            const bool lat = (u.pm % 17) != 0; const int tb = (u.pm / 17) * TB + CTXL;
            const int p0 = wc * 32 + 8 * fq, colb = h * 256 + p0;
#pragma unroll
            for (int ai = 0; ai < 2; ++ai)
#pragma unroll
                for (int m = 0; m < 4; ++m) { const int row = row0 + ai * HALF + m * 16;
                    f32x4 o1a = acc[ai][0][m][0], o1b = acc[ai][0][m][1], o2a = acc[ai][1][m][0], o2b = acc[ai][1][m][1];
                    if (lat) { const size_t to = (size_t)(row - tb) * 128 + p0;
                        const f32x4 ca = *(const f32x4*)(rc + to), cb = *(const f32x4*)(rc + to + 4), sa = *(const f32x4*)(rs + to), sb = *(const f32x4*)(rs + to + 4);
                        const f32x4 x1a = o1a, x1b = o1b, x2a = o2a, x2b = o2b;
                        o1a = x1a * ca - x2a * sa; o2a = x1a * sa + x2a * ca; o1b = x1b * cb - x2b * sb; o2b = x1b * sb + x2b * cb; }
                    bf16_t* rowp = dst + (size_t)row * DM + colb;
                    *(u32x4*)rowp = pack8(o1a * sc, o1b * sc); *(u32x4*)(rowp + 128) = pack8(o2a * sc, o2b * sc); }
        }
    }
};

template <class Epi, class Sched, bool ALIGN_EPI = false, bool SP2 = false>
__device__ __forceinline__ void gemm_phase(const int tid, PG8_LAS unsigned char* lds, const Gemm g, const Sched& S, const Epi& E) {
    const int wid = __builtin_amdgcn_readfirstlane(tid >> 6), lane = tid & 63, wr = wid >> 2, wc = wid & 3, fr = lane & 15, fq = lane >> 4;
    const int K = g.K;
    unsigned voffA[2], voffB[2];
#pragma unroll
    for (int i = 0; i < 2; ++i) { int R, C; stage_rc(tid * 16 + i * 8192, R, C); const int Rb = Epi::PERM ? ((R & ~31) + perm32(R & 31)) : R;
        voffA[i] = (unsigned)(R * K + C) * 2u; voffB[i] = (unsigned)(Rb * K + C) * 2u; }
    const size_t kstep = (size_t)(BK * 2);
    const size_t hstep = (size_t)HALF * K * 2;
    const size_t tstep = 2 * hstep;
    const unsigned ldsw = (unsigned)wid * 1024u;
    const int aoff = lds_byte(wr * 64 + fr, fq * 8), boff = lds_byte(wc * 32 + fr, fq * 8);
#define PG8_SA(b, h) (((b) * 2 + (h)) * HTB)
#define PG8_SB(b, h) ((4 + (b) * 2 + (h)) * HTB)
#define PG8_STAGE(bufoff, gbase, voff) do { _Pragma("unroll") for (int _i = 0; _i < 2; ++_i) \
        __builtin_amdgcn_global_load_lds((const unsigned*)((const char*)(gbase) + (voff)[_i]), (PG8_LAS unsigned*)(lds + (bufoff) + ldsw + _i * 8192), 16, 0, 0); } while (0)
#define PG8_LDA(dst, b, h) do { _Pragma("unroll") for (int m = 0; m < 4; ++m) _Pragma("unroll") for (int k = 0; k < 2; ++k) dst[m][k] = *(const PG8_LAS bf16x8*)(lds + PG8_SA(b, h) + aoff + m * 2048 + k * 1024); } while (0)
#define PG8_LDB(dst, b, h) do { _Pragma("unroll") for (int n = 0; n < 2; ++n) _Pragma("unroll") for (int k = 0; k < 2; ++k) dst[n][k] = *(const PG8_LAS bf16x8*)(lds + PG8_SB(b, h) + boff + n * 2048 + k * 1024); } while (0)
#define PG8_MMA(ai, bj, At, Bt) do { __builtin_amdgcn_s_setprio(1); _Pragma("unroll") for (int m = 0; m < 4; ++m) _Pragma("unroll") for (int n = 0; n < 2; ++n) _Pragma("unroll") for (int k = 0; k < 2; ++k) \
        acc[ai][bj][m][n] = __builtin_amdgcn_mfma_f32_16x16x32_bf16(Bt[n][k], At[m][k], acc[ai][bj][m][n], 0, 0, 0); __builtin_amdgcn_s_setprio(0); } while (0)
#define PG8_WAIT_V(n) asm volatile("s_waitcnt vmcnt(" #n ")" ::: "memory")
#define PG8_WAIT_L(n) asm volatile("s_waitcnt lgkmcnt(" #n ")" ::: "memory")
#define PG8_BAR __builtin_amdgcn_s_barrier()
#define PG8_SCHED __builtin_amdgcn_sched_barrier(0)
    Unit cur, nxt; int ui = 0;
    if (!S.next(0, cur)) return;
    f32x4 acc[2][2][4][2];
#pragma unroll
    for (int a = 0; a < 2; ++a)
#pragma unroll
        for (int b = 0; b < 2; ++b)
#pragma unroll
            for (int m = 0; m < 4; ++m)
#pragma unroll
                for (int n = 0; n < 2; ++n) acc[a][b][m][n] = (f32x4){0.f, 0.f, 0.f, 0.f};
    bf16x8 At[4][2], B0[2][2], B1[2][2];
    const char* cA = (const char*)g.A + (size_t)cur.pm * tstep + (size_t)cur.k0 * kstep; const char* cB = (const char*)g.Bt + (size_t)cur.pn * tstep + (size_t)cur.k0 * kstep;
    int nt = cur.nt;
    S.a_ready(cur);
    if constexpr (SP2) {
        PG8_STAGE(PG8_SB(0, 0), cB, voffB); PG8_STAGE(PG8_SB(0, 1), cB + hstep, voffB); PG8_STAGE(PG8_SA(0, 0), cA, voffA); PG8_STAGE(PG8_SA(0, 1), cA + hstep, voffA);
        if (wr == 1) PG8_BAR;
        PG8_WAIT_V(2); PG8_BAR;
        PG8_STAGE(PG8_SB(1, 0), cB + kstep, voffB); PG8_STAGE(PG8_SA(1, 0), cA + kstep, voffA); PG8_STAGE(PG8_SB(1, 1), cB + hstep + kstep, voffB);
        PG8_WAIT_V(6); PG8_BAR;
    } else {
        PG8_STAGE(PG8_SB(0, 0), cB, voffB); PG8_STAGE(PG8_SA(0, 0), cA, voffA); PG8_STAGE(PG8_SB(0, 1), cB + hstep, voffB); PG8_STAGE(PG8_SA(0, 1), cA + hstep, voffA);
        if (wr == 1) PG8_BAR;
        PG8_WAIT_V(4); PG8_BAR;
        PG8_STAGE(PG8_SB(1, 0), cB + kstep, voffB); PG8_STAGE(PG8_SA(1, 0), cA + kstep, voffA); PG8_STAGE(PG8_SB(1, 1), cB + hstep + kstep, voffB);
        PG8_WAIT_V(6); PG8_BAR;
    }
    for (;;) {
        const bool has_next = S.next(ui + 1, nxt);
        const char* nA = has_next ? (const char*)g.A + (size_t)nxt.pm * tstep + (size_t)nxt.k0 * kstep : cA; const char* nB = has_next ? (const char*)g.Bt + (size_t)nxt.pn * tstep + (size_t)nxt.k0 * kstep : cB;
        for (int t = 0; t < nt; t += 2) {
            const bool last = (t == nt - 2);
            const char* a1 = cA + (size_t)(t + 1) * kstep;
            const char* a2 = last ? nA : cA + (size_t)(t + 2) * kstep; const char* b2 = last ? nB : cB + (size_t)(t + 2) * kstep;
            const char* a3 = a2 + kstep; const char* b3 = b2 + kstep;
            if (last && has_next) S.a_ready(nxt);
            if constexpr (SP2) {
            PG8_LDB(B0, 0, 0); PG8_LDB(B1, 0, 1); PG8_SCHED; PG8_LDA(At, 0, 0); PG8_STAGE(PG8_SA(1, 1), a1 + hstep, voffA);
            PG8_WAIT_V(8); PG8_WAIT_L(0); PG8_BAR; PG8_MMA(0, 0, At, B0); PG8_MMA(0, 1, At, B1); PG8_BAR; PG8_SCHED;
            PG8_LDA(At, 0, 1); PG8_STAGE(PG8_SB(0, 0), b2, voffB); PG8_STAGE(PG8_SB(0, 1), b2 + hstep, voffB); PG8_STAGE(PG8_SA(0, 0), a2, voffA);
            PG8_WAIT_V(8); PG8_WAIT_L(0); PG8_BAR; PG8_MMA(1, 0, At, B0); PG8_MMA(1, 1, At, B1); PG8_BAR; PG8_SCHED;
            PG8_LDB(B0, 1, 0); PG8_LDB(B1, 1, 1); PG8_SCHED; PG8_LDA(At, 1, 0); PG8_STAGE(PG8_SA(0, 1), a2 + hstep, voffA);
            PG8_WAIT_V(8); PG8_WAIT_L(0); PG8_BAR; PG8_MMA(0, 0, At, B0); PG8_MMA(0, 1, At, B1); PG8_BAR; PG8_SCHED;
            PG8_LDA(At, 1, 1); PG8_STAGE(PG8_SB(1, 0), b3, voffB); PG8_STAGE(PG8_SB(1, 1), b3 + hstep, voffB); PG8_STAGE(PG8_SA(1, 0), a3, voffA);
            PG8_WAIT_V(8); PG8_WAIT_L(0); PG8_BAR; PG8_MMA(1, 0, At, B0); PG8_MMA(1, 1, At, B1); PG8_BAR; PG8_SCHED;
            } else {
            PG8_LDB(B0, 0, 0); PG8_SCHED; PG8_LDA(At, 0, 0); PG8_STAGE(PG8_SA(1, 1), a1 + hstep, voffA);
            PG8_WAIT_L(8); PG8_BAR; PG8_WAIT_L(0); PG8_MMA(0, 0, At, B0); PG8_BAR; PG8_SCHED;
            PG8_LDB(B1, 0, 1); PG8_STAGE(PG8_SB(0, 0), b2, voffB);
            PG8_BAR; PG8_WAIT_L(0); PG8_MMA(0, 1, At, B1); PG8_BAR;
            PG8_LDA(At, 0, 1); PG8_STAGE(PG8_SA(0, 0), a2, voffA);
            PG8_BAR; PG8_WAIT_L(0); PG8_MMA(1, 0, At, B0); PG8_BAR; PG8_SCHED;
            PG8_STAGE(PG8_SB(0, 1), b2 + hstep, voffB);
            PG8_WAIT_V(6); PG8_BAR; PG8_MMA(1, 1, At, B1); PG8_BAR;
            PG8_LDB(B0, 1, 0); PG8_SCHED; PG8_LDA(At, 1, 0); PG8_STAGE(PG8_SA(0, 1), a2 + hstep, voffA);
            PG8_WAIT_L(8); PG8_BAR; PG8_WAIT_L(0); PG8_MMA(0, 0, At, B0); PG8_BAR; PG8_SCHED;
            PG8_LDB(B1, 1, 1); PG8_STAGE(PG8_SB(1, 0), b3, voffB);
            PG8_BAR; PG8_WAIT_L(0); PG8_MMA(0, 1, At, B1); PG8_BAR;
            PG8_LDA(At, 1, 1); PG8_STAGE(PG8_SA(1, 0), a3, voffA);
            PG8_BAR; PG8_WAIT_L(0); PG8_MMA(1, 0, At, B0); PG8_BAR; PG8_SCHED;
            PG8_STAGE(PG8_SB(1, 1), b3 + hstep, voffB);
            PG8_WAIT_V(6); PG8_BAR; PG8_MMA(1, 1, At, B1); PG8_BAR;
            }
        }
        if constexpr (ALIGN_EPI) { if (wr == 0) PG8_BAR; }
        if constexpr (!Epi::AFTER_DRAIN) { E(acc, cur, wr, wc, fr, fq); S.done(cur); }
        if (!has_next) break;
#pragma unroll
        for (int a = 0; a < 2; ++a)
#pragma unroll
            for (int b = 0; b < 2; ++b)
#pragma unroll
                for (int m = 0; m < 4; ++m)
#pragma unroll
                    for (int n = 0; n < 2; ++n) acc[a][b][m][n] = (f32x4){0.f, 0.f, 0.f, 0.f};
        cur = nxt; cA = nA; cB = nB; nt = nxt.nt; ++ui;
        if constexpr (ALIGN_EPI) { if (wr == 1) PG8_BAR; }
    }
    PG8_WAIT_V(0);
    if constexpr (!ALIGN_EPI) { if (wr == 0) PG8_BAR; }
    PG8_BAR;
    if constexpr (Epi::AFTER_DRAIN) { E.fused(acc, cur, wr, wc, fr, fq, lds, wid, lane); S.done(cur); }
#undef PG8_SA
#undef PG8_SB
#undef PG8_STAGE
#undef PG8_LDA
#undef PG8_LDB
#undef PG8_MMA
#undef PG8_WAIT_V
#undef PG8_WAIT_L
#undef PG8_BAR
#undef PG8_SCHED
}
}
namespace att {
typedef unsigned short bf16;
constexpr int   D = 128, NW = 8, QBLK = 32, KVBLK = 64;
constexpr float SCALE = 0.088388347648318440f;
constexpr float THR = 8.f;
#ifndef ATT_SDEPTH
#define ATT_SDEPTH 1
#endif
constexpr int SDEPTH = ATT_SDEPTH;
constexpr size_t SHM_V = KVBLK * D * 2, SHM_K = KVBLK * D * 2, SHM_ATTN = 2 * SHM_V + 2 * SHM_K + NW * 64 * 4;
using bf16x8 = __attribute__((ext_vector_type(8))) short;
using s16x4  = __attribute__((ext_vector_type(4))) short;
using f32x16 = __attribute__((ext_vector_type(16))) float;
using f32x8  = __attribute__((ext_vector_type(8))) float;
using u32x4  = __attribute__((ext_vector_type(4))) unsigned;
#define KSWZ(row, colB) ((row) * 256 + ((colB) ^ (((row) & 7) << 4)))
#define SBAR() __builtin_amdgcn_sched_barrier(0)
__device__ __forceinline__ int crow(int r, int hi) { return (r & 3) + 8 * (r >> 2) + 4 * hi; }
__device__ __forceinline__ unsigned cvtpk(float lo, float hi) {
  unsigned r; asm volatile("v_cvt_pk_bf16_f32 %0, %1, %2" : "=v"(r) : "v"(lo), "v"(hi)); return r;
}
__device__ __forceinline__ void partialSM(f32x16& p0, f32x16& p1, float& m_reg, float& mn, float& alpha) {
  constexpr float C = SCALE * 1.4426950408889634f;
  float pmax = p0[0]; for (int r = 1; r < 16; ++r) pmax = fmaxf(pmax, p0[r]); for (int r = 0; r < 16; ++r) pmax = fmaxf(pmax, p1[r]);
  { auto rr = __builtin_amdgcn_permlane32_swap(__float_as_uint(pmax), __float_as_uint(pmax), false, false);
    pmax = fmaxf(__uint_as_float(rr[0]), __uint_as_float(rr[1])); }
  if (__builtin_expect(__all(pmax - m_reg <= THR / SCALE), 1)) { mn = m_reg; alpha = 1.f; }
  else { mn = fmaxf(m_reg, pmax); alpha = __builtin_amdgcn_exp2f((m_reg - mn) * C); m_reg = mn; }
  float mnC = -mn * C;
  for (int r = 0; r < 16; ++r) p0[r] = fmaf(p0[r], C, mnC); for (int r = 0; r < 16; ++r) p1[r] = fmaf(p1[r], C, mnC);
  for (int r = 0; r < 16; ++r) p0[r] = __builtin_amdgcn_exp2f(p0[r]);
}
__device__ __forceinline__ void finishSM(f32x16& p0, f32x16& p1, float alpha, float& l_reg, bf16x8& pa0, bf16x8& pa1, bf16x8& pa2, bf16x8& pa3) {
  for (int r = 0; r < 16; ++r) p1[r] = __builtin_amdgcn_exp2f(p1[r]);
  float ps = 0; for (int r = 0; r < 16; ++r) ps += p0[r]; for (int r = 0; r < 16; ++r) ps += p1[r];
  { auto rr = __builtin_amdgcn_permlane32_swap(__float_as_uint(ps), __float_as_uint(ps), false, false);
    ps = __uint_as_float(rr[0]) + __uint_as_float(rr[1]); }
  l_reg = l_reg * alpha + ps;
#define PK4(P, BASE, OUT) do { unsigned a0 = cvtpk(P[BASE + 0], P[BASE + 1]), a1 = cvtpk(P[BASE + 2], P[BASE + 3]);   \
    unsigned b0 = cvtpk(P[BASE + 4], P[BASE + 5]), b1 = cvtpk(P[BASE + 6], P[BASE + 7]);                              \
    auto r0 = __builtin_amdgcn_permlane32_swap(a0, b0, false, false); auto r1 = __builtin_amdgcn_permlane32_swap(a1, b1, false, false); \
    u32x4 w = {r0[0], r1[0], r0[1], r1[1]}; OUT = *reinterpret_cast<bf16x8*>(&w); } while (0)
  PK4(p0, 0, pa0); PK4(p0, 8, pa1); PK4(p1, 0, pa2); PK4(p1, 8, pa3);
#undef PK4
}
__device__ __forceinline__ void qkt(f32x16& p0, f32x16& p1, const bf16* Ks, const bf16x8* qr, int r32, int hi) {
  p0 = f32x16{}; p1 = f32x16{};
  for (int d0 = 0; d0 < 8; ++d0) { int cb = (d0 * 16 + hi * 8) * 2;
    bf16x8 b0 = *reinterpret_cast<const bf16x8*>((const char*)Ks + KSWZ(r32, cb));
    bf16x8 b1 = *reinterpret_cast<const bf16x8*>((const char*)Ks + KSWZ(32 + r32, cb));
    p0 = __builtin_amdgcn_mfma_f32_32x32x16_bf16(b0, qr[d0], p0, 0, 0, 0);
    p1 = __builtin_amdgcn_mfma_f32_32x32x16_bf16(b1, qr[d0], p1, 0, 0, 0); }
}
__device__ __forceinline__ int v_st(int k, int c) { const int kk = (k & ~0xC) | ((k & 4) << 1) | ((k & 8) >> 1); return ((kk >> 3) * 4 + (c >> 5)) * 512 + ((kk & 7) * 32 + (c & 31)) * 2; }
__device__ __forceinline__ int v_rd_base(int lane) { return ((lane & 3) << 3) | (((lane >> 2) & 3) << 6) | (((lane >> 4) & 1) << 5) | (((lane >> 5) & 1) << 8); }
constexpr int v_rd_off(int d0, int ks, int half) { return d0 * 512 + ks * 4096 + half * 2048; }
template <int OFF> __device__ __forceinline__ s16x4 tr_read(int vb) {
  s16x4 r; asm volatile("ds_read_b64_tr_b16 %0, %1 offset:%2" : "=&v"(r) : "v"(vb), "i"(OFF) : "memory"); return r;
}
template <int D0> __device__ __forceinline__ void pv_one(f32x16& od, int vb, bf16x8 pa0, bf16x8 pa1, bf16x8 pa2, bf16x8 pa3) {
  const s16x4 l0 = tr_read<v_rd_off(D0, 0, 0)>(vb), h0 = tr_read<v_rd_off(D0, 0, 1)>(vb), l1 = tr_read<v_rd_off(D0, 1, 0)>(vb), h1 = tr_read<v_rd_off(D0, 1, 1)>(vb);
  const s16x4 l2 = tr_read<v_rd_off(D0, 2, 0)>(vb), h2 = tr_read<v_rd_off(D0, 2, 1)>(vb), l3 = tr_read<v_rd_off(D0, 3, 0)>(vb), h3 = tr_read<v_rd_off(D0, 3, 1)>(vb);
  asm volatile("s_waitcnt lgkmcnt(0)" ::: "memory"); SBAR();
#define PK(L, H) (bf16x8){L[0], L[1], L[2], L[3], H[0], H[1], H[2], H[3]}
  od = __builtin_amdgcn_mfma_f32_32x32x16_bf16(pa0, PK(l0, h0), od, 0, 0, 0);
  od = __builtin_amdgcn_mfma_f32_32x32x16_bf16(pa1, PK(l1, h1), od, 0, 0, 0);
  od = __builtin_amdgcn_mfma_f32_32x32x16_bf16(pa2, PK(l2, h2), od, 0, 0, 0);
  od = __builtin_amdgcn_mfma_f32_32x32x16_bf16(pa3, PK(l3, h3), od, 0, 0, 0);
#undef PK
}
__device__ __forceinline__ void pv_d0(f32x16* o, int vb, bf16x8 pa0, bf16x8 pa1, bf16x8 pa2, bf16x8 pa3) {
  pv_one<0>(o[0], vb, pa0, pa1, pa2, pa3); pv_one<1>(o[1], vb, pa0, pa1, pa2, pa3); pv_one<2>(o[2], vb, pa0, pa1, pa2, pa3); pv_one<3>(o[3], vb, pa0, pa1, pa2, pa3);
}

template <int LDQ, int LDK, int LDO>
__device__ __forceinline__ void attn_dense_body(const int tid, const bf16* __restrict__ Qb, const bf16* __restrict__ Kh, const bf16* __restrict__ Vh,
                                                float* __restrict__ Ob, int seq, char* lds) {

  const int wid = tid >> 6, lane = tid & 63, r32 = lane & 31, hi = lane >> 5;
  bf16* V_lds = (bf16*)lds; bf16* K_lds = (bf16*)(lds + 2 * SHM_V);
  float* ws = (float*)(lds + 2 * SHM_V + 2 * SHM_K) + wid * 64; float* li_l = ws; float* al_l = ws + 32;
  float m_reg = -1e30f, l_reg = 0; f32x16 o[4] = {}; bf16x8 qr[8];
  const bf16* Qw = Qb + (long)(wid * QBLK + r32) * LDQ + hi * 8;
#pragma unroll
  for (int d0 = 0; d0 < 8; ++d0) qr[d0] = *reinterpret_cast<const bf16x8*>(Qw + d0 * 16);
  const int sr = tid >> 4, sc = (tid & 15) * 8, vst0 = v_st(sr, sc), vst1 = v_st(32 + sr, sc);
  const int vb0 = (int)(uintptr_t)V_lds + v_rd_base(lane);
  struct { bf16x8 vs0, vs1, ks0, ks1; } sr_[SDEPTH];
#define SLOAD(i, k0) do { sr_[i].vs0 = (*reinterpret_cast<const bf16x8*>(&Vh[(long)((k0) + sr) * LDK + sc])); sr_[i].vs1 = (*reinterpret_cast<const bf16x8*>(&Vh[(long)((k0) + 32 + sr) * LDK + sc])); \
    sr_[i].ks0 = (*reinterpret_cast<const bf16x8*>(&Kh[(long)((k0) + sr) * LDK + sc])); sr_[i].ks1 = (*reinterpret_cast<const bf16x8*>(&Kh[(long)((k0) + 32 + sr) * LDK + sc])); } while (0)
#define SWRITE(b, i) do { *(bf16x8*)((char*)V_lds + (b) * SHM_V + vst0) = sr_[i].vs0;          \
    *(bf16x8*)((char*)V_lds + (b) * SHM_V + vst1) = sr_[i].vs1; int kc = sc * 2;               \
    *(bf16x8*)((char*)K_lds + (b) * SHM_K + KSWZ(sr, kc)) = sr_[i].ks0;                       \
    *(bf16x8*)((char*)K_lds + (b) * SHM_K + KSWZ(32 + sr, kc)) = sr_[i].ks1; } while (0)
#define SWAIT() do { if constexpr (SDEPTH == 2) asm volatile("s_waitcnt vmcnt(4)" ::: "memory"); else asm volatile("s_waitcnt vmcnt(0)" ::: "memory"); } while (0)
#define RESC(a) do { if (__any((a) < 1.f)) { if (hi == 0) al_l[r32] = (a); asm volatile("s_waitcnt lgkmcnt(0)" ::: "memory"); \
    for (int d = 0; d < 4; ++d) for (int r = 0; r < 16; ++r) o[d][r] *= al_l[crow(r, hi)]; } } while (0)
  f32x16 pA0, pA1, pB0, pB1; float mnA, mnB, alA, alB; bf16x8 pa0, pa1, pa2, pa3; const int NT = seq / KVBLK;
  constexpr int SE = 0, SO = SDEPTH - 1;
  SLOAD(SE, 0); asm volatile("s_waitcnt vmcnt(0)" ::: "memory"); SWRITE(0, SE); __syncthreads();
  qkt(pA0, pA1, K_lds, qr, r32, hi); partialSM(pA0, pA1, m_reg, mnA, alA);
  SLOAD(SO, KVBLK); if constexpr (SDEPTH == 2) { if (2 < NT) SLOAD(SE, 2 * KVBLK); }
  SWAIT(); SWRITE(1, SO); __syncthreads();
  for (int j = 1; j + 1 < NT; j += 2) {
    SBAR(); qkt(pB0, pB1, (bf16*)((char*)K_lds + SHM_K), qr, r32, hi);
    finishSM(pA0, pA1, alA, l_reg, pa0, pa1, pa2, pa3); SBAR();
    SLOAD(SO, (j + SDEPTH) * KVBLK); SBAR();
    pv_d0(o, vb0, pa0, pa1, pa2, pa3); partialSM(pB0, pB1, m_reg, mnB, alB);
    __syncthreads(); SWAIT(); SWRITE(0, SE);
    RESC(alB); __syncthreads();
    SBAR(); qkt(pA0, pA1, K_lds, qr, r32, hi);
    finishSM(pB0, pB1, alB, l_reg, pa0, pa1, pa2, pa3); SBAR();
    if (SDEPTH == 1 || j + 3 < NT) SLOAD(SE, (j + 1 + SDEPTH) * KVBLK); SBAR();
    pv_d0(o, vb0 + (int)SHM_V, pa0, pa1, pa2, pa3); partialSM(pA0, pA1, m_reg, mnA, alA);
    __syncthreads(); SWAIT(); SWRITE(1, SO);
    RESC(alA); __syncthreads();
  }
  SBAR(); qkt(pB0, pB1, (bf16*)((char*)K_lds + SHM_K), qr, r32, hi);
  finishSM(pA0, pA1, alA, l_reg, pa0, pa1, pa2, pa3); SBAR();
  pv_d0(o, vb0, pa0, pa1, pa2, pa3); partialSM(pB0, pB1, m_reg, mnB, alB);
  __syncthreads(); RESC(alB);
  finishSM(pB0, pB1, alB, l_reg, pa0, pa1, pa2, pa3); SBAR();
  pv_d0(o, vb0 + (int)SHM_V, pa0, pa1, pa2, pa3);
  if (hi == 0) li_l[r32] = l_reg; asm volatile("s_waitcnt lgkmcnt(0)" ::: "memory");
  float rli[16];
#pragma unroll
  for (int r = 0; r < 16; ++r) rli[r] = __builtin_amdgcn_rcpf(li_l[crow(r, hi)]);
  float* Ow = Ob + (long)(wid * QBLK) * LDO;
#pragma unroll
  for (int r = 0; r < 16; ++r) { int orow = crow(r, hi);
    for (int d0 = 0; d0 < 4; ++d0) Ow[(long)orow * LDO + d0 * 32 + r32] = o[d0][r] * rli[r]; }
#undef SLOAD
#undef SWRITE
#undef SWAIT
#undef RESC
}
}
#define GAS __attribute__((address_space(1)))
#define LAS __attribute__((address_space(3)))
typedef unsigned short bf16;
typedef unsigned v4u __attribute__((ext_vector_type(4)));
typedef unsigned v2u __attribute__((ext_vector_type(2)));
typedef float f32x4 __attribute__((ext_vector_type(4)));
typedef short bf16x8 __attribute__((ext_vector_type(8)));
typedef GAS unsigned gu32;
#define RLX_AGENT __ATOMIC_RELAXED, __HIP_MEMORY_SCOPE_AGENT
#define LDS_WAIT() asm volatile("s_waitcnt lgkmcnt(0)" ::: "memory")
#define LDS_BARRIER() do { asm volatile("s_waitcnt lgkmcnt(0)" ::: "memory"); __builtin_amdgcn_s_barrier(); asm volatile("" ::: "memory"); } while (0)
#define VM_WAIT() asm volatile("s_waitcnt vmcnt(0)" ::: "memory")
__device__ __forceinline__ unsigned f2bf(float f) { unsigned u = __builtin_bit_cast(unsigned, f); return (u + 0x7fffu + ((u >> 16) & 1u)) >> 16; }
__device__ __forceinline__ unsigned pk2(float lo, float hi) { return f2bf(lo) | (f2bf(hi) << 16); }
__device__ __forceinline__ float bf_lo(unsigned w) { return __builtin_bit_cast(float, w << 16); }
__device__ __forceinline__ float bf_hi(unsigned w) { return __builtin_bit_cast(float, w & 0xffff0000u); }
__device__ __forceinline__ float wave_sum(float v) {
#pragma unroll
    for (int o = 1; o < 64; o <<= 1) v += __shfl_xor(v, o);
    return v;
}
__device__ __forceinline__ f32x4 mfma16(bf16x8 a, bf16x8 b, f32x4 c) { return __builtin_amdgcn_mfma_f32_16x16x32_bf16(a, b, c, 0, 0, 0); }

__device__ __forceinline__ const float* in_ptr(const LAS unsigned long long* TBL, int i) {
    const unsigned long long v = TBL[i]; const unsigned lo = __builtin_amdgcn_readfirstlane((unsigned)v), hi = __builtin_amdgcn_readfirstlane((unsigned)(v >> 32));
    return (const float*)(const GAS float*)(uintptr_t)(((unsigned long long)hi << 32) | lo);
}
#define INP(i) in_ptr(TBL, i)

typedef short v4i16_t __attribute__((ext_vector_type(4)));
__device__ __forceinline__ v4i16_t lds_tr(const LAS unsigned char* p) { return __builtin_amdgcn_ds_read_tr16_b64_v4i16((LAS v4i16_t*)p); }
__device__ __forceinline__ bf16x8 cat8(v4i16_t lo, v4i16_t hi) { return __builtin_shufflevector(lo, hi, 0, 1, 2, 3, 4, 5, 6, 7); }
__device__ __forceinline__ int imgb_off(int row, int ch) { return 256 * row + 16 * (ch ^ (((row & 3) << 2) | ((row >> 2) & 3))); }

#define XB_TMO      128
#define XB_XCNT(j)  (256  + 64 * (j))
#define XB_XSUB(j)  (1280 + 64 * (j))
#define XB_XGEN(j)  (2304 + 64 * (j))
#define XB_TOP      3328
#define XB_TOPGEN   3392
#define XCD_BAR_WORDS 3456
#define XB_SPIN_CAP (1u << 18)

__device__ __forceinline__ unsigned xb_ld(unsigned* p)              { return __hip_atomic_load(p, __ATOMIC_RELAXED, __HIP_MEMORY_SCOPE_AGENT); }
__device__ __forceinline__ unsigned xb_add(unsigned* p, unsigned v) { return __hip_atomic_fetch_add(p, v, __ATOMIC_RELAXED, __HIP_MEMORY_SCOPE_AGENT); }
__device__ __forceinline__ unsigned xb_xcc_id() { return (unsigned)__builtin_amdgcn_s_getreg((3 << 11) | 20) & 0xFu; }
#define XB_SPIN(cond, bar) do { unsigned _sp = 0; while (cond) { __builtin_amdgcn_s_sleep(1); \
    if ((++_sp & 255u) == 0u) { if (xb_ld(&(bar)[XB_TMO])) break; if (_sp > XB_SPIN_CAP) { atomicAdd(&(bar)[XB_TMO], 1u); break; } } } } while (0)

struct XcdBarrier {
    unsigned* bar; unsigned x;
    volatile LAS unsigned* st;
};

__device__ __forceinline__ XcdBarrier xcd_barrier_post(unsigned* bar, volatile LAS unsigned* st) {
    XcdBarrier b; b.bar = bar; b.x = xb_xcc_id(); b.st = st;
    if (threadIdx.x == 0) (void)xb_add(&bar[XB_XCNT(b.x)], 1u);
    return b;
}
__device__ __forceinline__ void xcd_barrier_complete(unsigned* bar, unsigned x, unsigned& nloc, unsigned& nx) {
    const unsigned G = gridDim.x * gridDim.y * gridDim.z;
    unsigned sum, cnt, mine, sp = 0u;
    for (;;) {
        sum = 0u; cnt = 0u; mine = 0u;
#pragma unroll
        for (unsigned j = 0; j < 16; ++j) { const unsigned c = xb_ld(&bar[XB_XCNT(j)]); sum += c; cnt += (c > 0u) ? 1u : 0u; mine = (j == x) ? c : mine; }
        if (sum == G) break;
        __builtin_amdgcn_s_sleep(1);
        if ((++sp & 255u) == 0u) { if (xb_ld(&bar[XB_TMO])) break; if (sp > XB_SPIN_CAP) { atomicAdd(&bar[XB_TMO], 1u); break; } }
    }
    nloc = mine > 0u ? mine : 1u; nx = cnt > 0u ? cnt : 1u;
}

__device__ __forceinline__ void xcd_barrier(const XcdBarrier& b) {
    asm volatile("s_waitcnt vmcnt(0)" ::: "memory");
    __syncthreads();
    if (threadIdx.x == 0) {
        unsigned* bar = b.bar;
        __builtin_amdgcn_s_waitcnt(0);
        unsigned nloc = b.st[0], nx = b.st[1];
        if (nloc == 0u) { xcd_barrier_complete(bar, b.x, nloc, nx); b.st[0] = nloc; b.st[1] = nx; }
        const unsigned old = xb_add(&bar[XB_XSUB(b.x)], 1u);
        const unsigned gen = old / nloc;
        if (old + 1u == (gen + 1u) * nloc) {
            __builtin_amdgcn_fence(__ATOMIC_RELEASE, "agent");
            asm volatile("s_waitcnt vmcnt(0)" ::: "memory");
            const unsigned og = xb_add(&bar[XB_TOP], 1u);
            const unsigned tg = og / nx;
            if (og + 1u == (tg + 1u) * nx) xb_add(&bar[XB_TOPGEN], 1u);
            else XB_SPIN(xb_ld(&bar[XB_TOPGEN]) == tg, bar);
            __builtin_amdgcn_fence(__ATOMIC_ACQUIRE, "agent");
            xb_add(&bar[XB_XGEN(b.x)], 1u);
            asm volatile("s_waitcnt vmcnt(0)" ::: "memory");
        } else {
            XB_SPIN(xb_ld(&bar[XB_XGEN(b.x)]) == gen, bar);
            __builtin_amdgcn_fence(__ATOMIC_ACQUIRE, "agent");
            asm volatile("s_waitcnt vmcnt(0)" ::: "memory");
        }
    }
    __syncthreads();
}
constexpr size_t MiB = 1u << 20;
constexpr size_t WS_CTL = 0, CTL_ZERO_BYTES = 1 * MiB;
constexpr size_t WS_MODP = 1 * MiB;
constexpr size_t WS_MOD = 6 * MiB;
constexpr size_t WS_RCDA = 7 * MiB, WS_RSDA = 8 * MiB;
constexpr size_t WS_RCRT = 9 * MiB, WS_RSRT = 11 * MiB;
constexpr size_t WS_VSS = 13 * MiB;
constexpr size_t WS_WQKV = 16 * MiB;
constexpr size_t WS_WODA = 64 * MiB;
constexpr size_t WS_WSGI = 80 * MiB, WS_WSGO = 96 * MiB;
constexpr size_t WS_WRET = 104 * MiB, WS_WRETO = 152 * MiB;
constexpr size_t WS_WGU = 168 * MiB;
constexpr size_t WS_WD = 344 * MiB;
constexpr size_t WS_X = 432 * MiB;
constexpr size_t WS_HN = 500 * MiB;
constexpr size_t WS_HID = 534 * MiB;
constexpr size_t WS_ACT = 628 * MiB;
constexpr size_t WS_SLAB = 1308 * MiB;
constexpr size_t WS_END = 1352 * MiB;
constexpr size_t A34 = 34 * MiB;
constexpr int CW_BAR = 4096;

constexpr int LDS_BYTES = 147456, MISC_OFF = 139264;

struct Args { const float* in[26]; float* out; unsigned char* ws; int ph_lo, ph_hi; };
enum { I_X = 0, I_C, I_CTX, I_CCTX, I_ADAW, I_ADAB, I_NMG, I_NFG, I_WGU, I_WD, I_DAQKV, I_DAO, I_DALAM, I_DASUB, I_SGIN, I_SGVG, I_SGWS, I_SGBS, I_SGOUT,
       I_RQ, I_RK, I_RV, I_RG, I_RO, I_RDEC, I_FNG };

struct TJob { const float* W; bf16* WT; int K, N, kind, row_off; };
__device__ __forceinline__ int dest_row(int kind, int n0) {
    if (kind == 1) {
        if (n0 >= 4096) return n0;
        const int sec = n0 >> 11, r = n0 & 2047, h = r >> 8, m = (r >> 7) & 1, hf = (r >> 6) & 1;
        return sec * 2048 + h * 256 + hf * 128 + m * 64;
    }
    if (kind == 2) {
        if (n0 < FFH) return (n0 >> 7) * 256 + (n0 & 127);
        const int n1 = n0 - FFH; return (n1 >> 7) * 256 + 128 + (n1 & 127);
    }
    return n0;
}
__device__ __forceinline__ void transpose_item(const TJob& J, int item, LAS bf16* scr, int lane) {
    const int nblk = J.N >> 6, kb = item / nblk, nb = item - kb * nblk, k0 = kb << 6, n0 = nb << 6;
    const int drow = J.row_off + dest_row(J.kind, n0);
    const float* src = J.W + (size_t)(k0 + (lane >> 4)) * J.N + n0 + 4 * (lane & 15);
    f32x4 v[16];
#pragma unroll
    for (int i = 0; i < 16; ++i) v[i] = *(const f32x4*)(src + (size_t)(4 * i) * J.N);
#pragma unroll
    for (int i = 0; i < 16; ++i) { const int kk = (lane >> 4) + 4 * i; LAS unsigned* d = (LAS unsigned*)(scr + kk * 66 + 4 * (lane & 15));
        d[0] = pg8::cvt_pk_bf16(v[i].x, v[i].y); d[1] = pg8::cvt_pk_bf16(v[i].z, v[i].w); }
    LDS_WAIT();
    const int c = lane & 7;
#pragma unroll
    for (int j = 0; j < 8; ++j) { const int n = (lane >> 3) + 8 * j; const LAS bf16* s = scr + (8 * c) * 66 + n;
        v4u o; o.x = (unsigned)s[0] | ((unsigned)s[66] << 16); o.y = (unsigned)s[132] | ((unsigned)s[198] << 16);
        o.z = (unsigned)s[264] | ((unsigned)s[330] << 16); o.w = (unsigned)s[396] | ((unsigned)s[462] << 16);
        *(v4u*)(J.WT + (size_t)(drow + n) * J.K + k0 + 8 * c) = o; }
    LDS_WAIT();
}
__device__ __forceinline__ void gemv_item(const float* ada_w, float* MODP, const LAS float* SC, int it, int lane) {
    const int l = it / 384, rem = it - l * 384, ks = rem / 48, nc = rem - ks * 48;
    const float* Wp = ada_w + ((size_t)l * 2048 + ks * 256) * 12288 + nc * 256 + 4 * lane;
    f32x4 a0 = {0.f, 0.f, 0.f, 0.f}, a1 = a0, a2 = a0;
    for (int k = 0; k < 256; k += 16) {
        f32x4 w[16];
#pragma unroll
        for (int i = 0; i < 16; ++i) w[i] = *(const f32x4*)(Wp + (size_t)(k + i) * 12288);
#pragma unroll
        for (int i = 0; i < 16; ++i) { const int kk = ks * 256 + k + i; const float s0 = SC[kk], s1 = SC[2048 + kk], s2 = SC[4096 + kk];
            a0 += w[i] * s0; a1 += w[i] * s1; a2 += w[i] * s2; }
    }
    float* o = MODP + ((size_t)(ks * 4 + l) * 3) * 12288 + nc * 256 + 4 * lane;
    *(f32x4*)o = a0; *(f32x4*)(o + 12288) = a1; *(f32x4*)(o + 24576) = a2;
}

__device__ __forceinline__ void prologue_phase(const LAS unsigned long long* TBL, unsigned char* ws, LAS unsigned char* lds, int tid, int lane, int wave, int gw, int NGW) {
    LAS float* SC = (LAS float*)(lds + 69632);
    for (int idx = tid; idx < 3 * 2048; idx += 512) { const float cv = (idx < 4096) ? INP(I_C)[idx] : INP(I_CCTX)[idx - 4096]; SC[idx] = cv / (1.0f + __expf(-cv)); }
    __syncthreads();
    LAS bf16* scr = (LAS bf16*)(lds + wave * 8448);
    constexpr int N_GEMV = 4 * 8 * 48, N_T = 53248, N_XC = MALL, N_ROPE = SEQ, N_ALL = N_GEMV + N_T + N_XC + N_ROPE;
    for (int it = gw; it < N_ALL; it += NGW) {
        if (it < N_GEMV) { gemv_item(INP(I_ADAW), (float*)(ws + WS_MODP), SC, it, lane); continue; }
        int r = it - N_GEMV;
        if (r < N_T) {
            TJob J; bool found = false;
#define TJ(src_, dst_, K_, N_, kind_, ro_) { const int n_ = ((K_) >> 6) * ((N_) >> 6); if (!found) { if (r < n_) { J.W = (src_); J.WT = (bf16*)(dst_); J.K = (K_); J.N = (N_); J.kind = (kind_); J.row_off = (ro_); found = true; } else r -= n_; } }
            TJ(INP(I_WGU), ws + WS_WGU, 2048, 11264, 2, 0)
            TJ(INP(I_WGU) + (size_t)1 * 2048 * 11264, ws + WS_WGU + 44 * MiB, 2048, 11264, 2, 0)
            TJ(INP(I_WGU) + (size_t)2 * 2048 * 11264, ws + WS_WGU + 88 * MiB, 2048, 11264, 2, 0)
            TJ(INP(I_WGU) + (size_t)3 * 2048 * 11264, ws + WS_WGU + 132 * MiB, 2048, 11264, 2, 0)
            TJ(INP(I_WD), ws + WS_WD, 5632, 2048, 0, 0)
            TJ(INP(I_WD) + (size_t)1 * 5632 * 2048, ws + WS_WD + 22 * MiB, 5632, 2048, 0, 0)
            TJ(INP(I_WD) + (size_t)2 * 5632 * 2048, ws + WS_WD + 44 * MiB, 5632, 2048, 0, 0)
            TJ(INP(I_WD) + (size_t)3 * 5632 * 2048, ws + WS_WD + 66 * MiB, 5632, 2048, 0, 0)
            TJ(INP(I_DAQKV), ws + WS_WQKV, 2048, 6144, 1, 0)
            TJ(INP(I_DAQKV) + (size_t)2048 * 6144, ws + WS_WQKV + 24 * MiB, 2048, 6144, 1, 0)
            TJ(INP(I_DAO), ws + WS_WODA, 2048, 2048, 0, 0)
            TJ(INP(I_DAO) + (size_t)2048 * 2048, ws + WS_WODA + 8 * MiB, 2048, 2048, 0, 0)
            TJ(INP(I_SGIN), ws + WS_WSGI, 2048, 4096, 0, 0)
            TJ(INP(I_SGOUT), ws + WS_WSGO, 2048, 2048, 0, 0)
            TJ(INP(I_RQ), ws + WS_WRET, 2048, 2048, 0, 0)
            TJ(INP(I_RK), ws + WS_WRET, 2048, 2048, 0, 2048)
            TJ(INP(I_RV), ws + WS_WRET, 2048, 4096, 0, 4096)
            TJ(INP(I_RG), ws + WS_WRET, 2048, 4096, 0, 8192)
            TJ(INP(I_RO), ws + WS_WRETO, 4096, 2048, 0, 0)
#undef TJ
            if (found) transpose_item(J, r, scr, lane);
            continue;
        }
        r -= N_T;
        if (r < N_XC) {
            const int b = r / TB, i = r - b * TB;
            const float* src = (i < CTXL) ? INP(I_CTX) + (size_t)(b * CTXL + i) * DM : INP(I_X) + (size_t)(b * SEQ + i - CTXL) * DM;
            float* dst = (float*)(ws + WS_X) + (size_t)r * DM;
#pragma unroll
            for (int j = 0; j < 8; ++j) *(f32x4*)(dst + 256 * j + 4 * lane) = *(const f32x4*)(src + 256 * j + 4 * lane);
            continue;
        }
        r -= N_XC;
        {
            const float rowp = (float)(r >> 6), colp = (float)(r & 63);
            { const int f = lane & 31; const float inv = __builtin_amdgcn_exp2f(-(float)f * (13.287712379549449f / 32.0f)); const float ang = ((lane < 32) ? rowp : colp) * inv;
              const float rev = ang * 0.15915494309189535f, fr = rev - floorf(rev);
              ((float*)(ws + WS_RCDA))[(size_t)r * 64 + lane] = __builtin_amdgcn_cosf(fr); ((float*)(ws + WS_RSDA))[(size_t)r * 64 + lane] = __builtin_amdgcn_sinf(fr); }
#pragma unroll
            for (int q = 0; q < 2; ++q) { const int j = lane + 64 * q, f = j & 63; const float inv = __builtin_amdgcn_exp2f(-(float)f * (13.287712379549449f / 64.0f)); const float ang = ((j < 64) ? rowp : colp) * inv;
              const float rev = ang * 0.15915494309189535f, fr = rev - floorf(rev);
              ((float*)(ws + WS_RCRT))[(size_t)r * 128 + j] = __builtin_amdgcn_cosf(fr); ((float*)(ws + WS_RSRT))[(size_t)r * 128 + j] = __builtin_amdgcn_sinf(fr); }
        }
    }
    __syncthreads();
}
__device__ __forceinline__ void modreduce_phase(const LAS unsigned long long* TBL, unsigned char* ws, int gtid, int gthreads) {
    const float* MODP = (const float*)(ws + WS_MODP); float* MOD = (float*)(ws + WS_MOD);
    for (int idx = gtid; idx < 36864; idx += gthreads) {
        const int e = idx * 4, l = e / 36864, rem = e - l * 36864, j = rem / 12288, n = rem - j * 12288;
        f32x4 s = *(const f32x4*)(INP(I_ADAB) + l * 12288 + n);
#pragma unroll
        for (int ks = 0; ks < 8; ++ks) s += *(const f32x4*)(MODP + ((size_t)(ks * 4 + l) * 3 + j) * 12288 + n);
        *(f32x4*)(MOD + e) = s;
    }
}
__device__ __forceinline__ void norm_phase(LAS unsigned char* lds, int tid, int lane, int gw, int NGW, float* X, bf16* HN, const float* gain, const float* modl, int sofs, int cofs, bool skipctx, const float* SL, int nslab, const float* sgate) {
    LAS float* A = (LAS float*)lds; LAS float* Bv = A + 3 * 2048;
    for (int idx = tid; idx < 3 * 2048; idx += 512) { const int j = idx >> 11, c = idx & 2047; A[idx] = gain[c] * (1.0f + modl[j * 12288 + cofs + c]); Bv[idx] = modl[j * 12288 + sofs + c]; }
    __syncthreads();
    for (int r = gw; r < MALL; r += NGW) {
        const int b = r / TB, i = r - b * TB, jv = (i < CTXL) ? 2 : b;
        if (skipctx && jv == 2) continue;
        float* xr = X + (size_t)r * DM + 4 * lane;
        f32x4 v[8]; float ss = 0.f;
#pragma unroll
        for (int j = 0; j < 8; ++j) v[j] = *(const f32x4*)(xr + 256 * j);
        if (jv == 2 && nslab > 0) {
            const float* sl = SL + (size_t)(b * CTXL + i) * DM + 4 * lane;
#pragma unroll
            for (int j = 0; j < 8; ++j) { f32x4 t = {0.f, 0.f, 0.f, 0.f};
                for (int s = 0; s < nslab; ++s) t += *(const f32x4*)(sl + (size_t)s * 512 * DM + 256 * j);
                v[j] += t * *(const f32x4*)(sgate + 256 * j + 4 * lane); *(f32x4*)(xr + 256 * j) = v[j]; }
        }
#pragma unroll
        for (int j = 0; j < 8; ++j) ss += (v[j].x * v[j].x + v[j].y * v[j].y) + (v[j].z * v[j].z + v[j].w * v[j].w);
        ss = wave_sum(ss); const float rstd = 1.0f / sqrtf(ss * (1.0f / 2048.0f) + EPSN);
        const LAS float* Aj = A + jv * 2048 + 4 * lane; const LAS float* Bj = Bv + jv * 2048 + 4 * lane;
        bf16* hr = HN + (size_t)r * DM + 4 * lane;
#pragma unroll
        for (int j = 0; j < 8; ++j) { const f32x4 aa = *(const LAS f32x4*)(Aj + 256 * j), bb = *(const LAS f32x4*)(Bj + 256 * j); const f32x4 h = v[j] * rstd * aa + bb;
            v2u o; o.x = pg8::cvt_pk_bf16(h.x, h.y); o.y = pg8::cvt_pk_bf16(h.z, h.w); *(v2u*)(hr + 256 * j) = o; }
    }
    __syncthreads();
}
__device__ __forceinline__ void final_norm_phase(int lane, int gw, int NGW, const float* X, float* out, const float* gain) {
    for (int r = gw; r < NB * SEQ; r += NGW) {
        const int b = r / SEQ, t = r - b * SEQ; const float* xr = X + (size_t)(b * TB + CTXL + t) * DM + 4 * lane;
        f32x4 v[8]; float ss = 0.f;
#pragma unroll
        for (int j = 0; j < 8; ++j) { v[j] = *(const f32x4*)(xr + 256 * j); ss += (v[j].x * v[j].x + v[j].y * v[j].y) + (v[j].z * v[j].z + v[j].w * v[j].w); }
        ss = wave_sum(ss); const float rstd = 1.0f / sqrtf(ss * (1.0f / 2048.0f) + EPSN);
        float* orow = out + (size_t)r * DM + 4 * lane;
#pragma unroll
        for (int j = 0; j < 8; ++j) *(f32x4*)(orow + 256 * j) = v[j] * rstd * *(const f32x4*)(gain + 256 * j + 4 * lane);
    }
}
__device__ __forceinline__ void da_attn_phase(char* ldsg, int tid, int vcu, int G, const bf16* Q, const bf16* K, const bf16* V, float* OF, bool need_ctx) {
    const int nlat = 1024, total = nlat + (need_ctx ? 64 : 0);
#pragma unroll 1
    for (int u = vcu; u < total; u += G) {
        int head, qb; if (u < nlat) { head = u >> 4; qb = 1 + (u & 15); } else { head = u - nlat; qb = 0; }
        const int b = head >> 5, h = (head >> 2) & 7, m = (head >> 1) & 1, vh = head & 1;
        const size_t rb = (size_t)b * TB;
        const bf16* Qb = Q + (rb + (size_t)qb * 256) * DM + h * 256 + m * 128;
        const bf16* Kh = K + rb * DM + h * 256 + m * 128;
        const bf16* Vh = V + rb * DM + h * 256 + vh * 128;
        float* Ob = OF + (rb + (size_t)qb * 256) * 4096 + (h * 2 + m) * 256 + vh * 128;
        att::attn_dense_body<DM, DM, 4096>(tid, Qb, Kh, Vh, Ob, qb == 0 ? CTXL : TB, ldsg);
        __syncthreads();
    }
}
__device__ __forceinline__ void da_combine_phase(int lane, int gw, int NGW, const float* OF, bf16* DAO, const float* lamv, const float* subg, float lambda_init, bool need_ctx) {
    float sa = lamv[lane] * lamv[128 + lane] + lamv[64 + lane] * lamv[192 + lane], sb = lamv[256 + lane] * lamv[384 + lane] + lamv[320 + lane] * lamv[448 + lane];
    sa = wave_sum(sa); sb = wave_sum(sb);
    const float lam = expf(sa) - expf(sb) + lambda_init, post = 1.0f - lambda_init;
    const f32x4 g4 = *(const f32x4*)(subg + 4 * lane) * post;
    for (int r = gw; r < MALL; r += NGW) {
        const int i = r % TB; if (!need_ctx && i < CTXL) continue;
        const float* orow = OF + (size_t)r * 4096 + 4 * lane; bf16* drow = DAO + (size_t)r * DM + 4 * lane;
#pragma unroll
        for (int h = 0; h < 8; ++h) {
            const f32x4 o1 = *(const f32x4*)(orow + h * 512), o2 = *(const f32x4*)(orow + h * 512 + 256); const f32x4 o = o1 - o2 * lam;
            float ss = (o.x * o.x + o.y * o.y) + (o.z * o.z + o.w * o.w); ss = wave_sum(ss);
            const float rstd = 1.0f / sqrtf(ss * (1.0f / 256.0f) + EPSN); const f32x4 y = o * rstd * g4;
            v2u w; w.x = pg8::cvt_pk_bf16(y.x, y.y); w.y = pg8::cvt_pk_bf16(y.z, y.w); *(v2u*)(drow + h * 256) = w;
        }
    }
}
__device__ __forceinline__ void sg_phase(LAS unsigned char* lds, int tid, int lane, int wave, int vcu, int G, const bf16* U, const bf16* V, const float* VSS,
                                         const float* w_s, const float* b_s, const float* v_gain, bf16* Gout) {
    LAS bf16* vL = (LAS bf16*)lds;
    LAS bf16* wL = (LAS bf16*)(lds + 33280);
    LAS float* rs = (LAS float*)(lds + 68096);
    const int l15 = lane & 15, l4 = lane >> 4;
    for (int unit = vcu; unit < 68 * 16; unit += G) {
        const int ci = unit >> 4, g = unit & 15, row0 = ci * 128;
        LDS_BARRIER();
        if (tid < 128) { const float* p = VSS + (size_t)(row0 + tid) * 32; float s = 0.f;
#pragma unroll
            for (int k = 0; k < 32; ++k) s += p[k];
            rs[tid] = 1.0f / sqrtf(s * (1.0f / 2048.0f) + EPSN); }
        { const int q = tid >> 2, c0 = (tid & 3) * 32; const v4u* src = (const v4u*)(V + (size_t)(row0 + q) * DM + g * 128 + c0); LAS unsigned* d = (LAS unsigned*)(vL + q * 130 + c0);
#pragma unroll
          for (int k = 0; k < 4; ++k) { const v4u x = src[k]; d[4 * k] = x.x; d[4 * k + 1] = x.y; d[4 * k + 2] = x.z; d[4 * k + 3] = x.w; } }
        LDS_BARRIER();
        { const int p = tid >> 2, q0 = (tid & 3) * 32; const float* src = w_s + ((size_t)g * 128 + p) * 128 + q0;
#pragma unroll
          for (int k = 0; k < 4; ++k) { const f32x4 a = *(const f32x4*)(src + 8 * k), b = *(const f32x4*)(src + 8 * k + 4); const LAS float* r8 = rs + q0 + 8 * k;
              const f32x4 ra = *(const LAS f32x4*)r8, rb = *(const LAS f32x4*)(r8 + 4);
              *(LAS v4u*)(wL + p * 136 + q0 + 8 * k) = pg8::pack8(a * ra, b * rb); } }
        LDS_BARRIER();
        bf16x8 aF[4];
#pragma unroll
        for (int kk = 0; kk < 4; ++kk) { const LAS bf16* s = vL + (32 * kk + 8 * l4) * 130 + 16 * wave + l15;
#pragma unroll
            for (int jj = 0; jj < 8; ++jj) aF[kk][jj] = (short)s[jj * 130]; }
        f32x4 acc[8];
#pragma unroll
        for (int pt = 0; pt < 8; ++pt) { acc[pt] = (f32x4){0.f, 0.f, 0.f, 0.f};
#pragma unroll
            for (int kk = 0; kk < 4; ++kk) { const bf16x8 bF = *(const LAS bf16x8*)(wL + (16 * pt + l15) * 136 + 32 * kk + 8 * l4); acc[pt] = mfma16(aF[kk], bF, acc[pt]); } }
        const int col = g * 128 + 16 * wave + 4 * l4; const f32x4 gn = *(const f32x4*)(v_gain + col);
#pragma unroll
        for (int pt = 0; pt < 8; ++pt) { const int p = 16 * pt + l15; const float bs = b_s[g * 128 + p]; const size_t off = (size_t)(row0 + p) * DM + col;
            const v2u uu = *(const v2u*)(U + off); const f32x4 sv = gn * acc[pt] + bs;
            v2u o; o.x = pg8::cvt_pk_bf16(bf_lo(uu.x) * sv.x, bf_hi(uu.x) * sv.y); o.y = pg8::cvt_pk_bf16(bf_lo(uu.y) * sv.z, bf_hi(uu.y) * sv.w); *(v2u*)(Gout + off) = o; }
    }
    __syncthreads();
}
__device__ __forceinline__ void ret_intra_phase(LAS unsigned char* lds, int tid, int lane, int wave, int vcu, int G, const bf16* Q, const bf16* K, const bf16* V, float* OI, const float* decay) {
    LAS bf16* PL = (LAS bf16*)lds;
    LAS bf16* vL = (LAS bf16*)(lds + 34816);
    const int l15 = lane & 15, l4 = lane >> 4;
    for (int unit = vcu; unit < 68 * 8; unit += G) {
        const int bc = unit >> 3, h = unit & 7, row0 = bc * 128;
        const float lgf = -expf(decay[h]) * 1.4426950408889634f, lgb = -expf(decay[8 + h]) * 1.4426950408889634f;
        LDS_BARRIER();
        { bf16x8 qF[8]; const bf16* qp = Q + (size_t)(row0 + 16 * wave + l15) * DM + h * 256 + 8 * l4;
#pragma unroll
          for (int kk = 0; kk < 8; ++kk) qF[kk] = *(const bf16x8*)(qp + 32 * kk);
          const int i = 16 * wave + l15;
#pragma unroll 2
          for (int jt = 0; jt < 8; ++jt) { const bf16* kp = K + (size_t)(row0 + 16 * jt + l15) * DM + h * 256 + 8 * l4; f32x4 acc = {0.f, 0.f, 0.f, 0.f};
#pragma unroll
              for (int kk = 0; kk < 8; ++kk) { const bf16x8 kF = *(const bf16x8*)(kp + 32 * kk); acc = mfma16(kF, qF[kk], acc); }
              float pv[4];
#pragma unroll
              for (int r = 0; r < 4; ++r) { const int j = 16 * jt + 4 * l4 + r; const int dd = i - j;
                  const float w = (dd > 0) ? __builtin_amdgcn_exp2f(lgf * (float)dd) : (dd < 0) ? __builtin_amdgcn_exp2f(lgb * (float)(-dd)) : 2.0f; pv[r] = acc[r] * w; }
              v2u o; o.x = pg8::cvt_pk_bf16(pv[0], pv[1]); o.y = pg8::cvt_pk_bf16(pv[2], pv[3]); *(LAS v2u*)(PL + i * 136 + 16 * jt + 4 * l4) = o; } }
        for (int ec = 0; ec < 4; ++ec) {
            LDS_BARRIER();
            { const int q = tid >> 2, c0 = (tid & 3) * 32; const v4u* src = (const v4u*)(V + (size_t)(row0 + q) * 4096 + h * 512 + ec * 128 + c0); LAS unsigned* d = (LAS unsigned*)(vL + q * 130 + c0);
#pragma unroll
              for (int k = 0; k < 4; ++k) { const v4u x = src[k]; d[4 * k] = x.x; d[4 * k + 1] = x.y; d[4 * k + 2] = x.z; d[4 * k + 3] = x.w; } }
            LDS_BARRIER();
            bf16x8 aF[4];
#pragma unroll
            for (int kk = 0; kk < 4; ++kk) { const LAS bf16* s = vL + (32 * kk + 8 * l4) * 130 + 16 * wave + l15;
#pragma unroll
                for (int jj = 0; jj < 8; ++jj) aF[kk][jj] = (short)s[jj * 130]; }
#pragma unroll
            for (int it = 0; it < 8; ++it) { f32x4 acc = {0.f, 0.f, 0.f, 0.f};
#pragma unroll
                for (int kk = 0; kk < 4; ++kk) { const bf16x8 bF = *(const LAS bf16x8*)(PL + (16 * it + l15) * 136 + 32 * kk + 8 * l4); acc = mfma16(aF[kk], bF, acc); }
                *(f32x4*)(OI + (size_t)(row0 + 16 * it + l15) * 4096 + h * 512 + ec * 128 + 16 * wave + 4 * l4) = acc; }
        }
    }
    __syncthreads();
}
__device__ __forceinline__ int ret_chunk_of(int dir, int step) { return (dir == 0) ? step : (step < 2 ? 1 - step : 35 - step); }
#define RCH(dir_, step_) (probe ? ((step_) & 1) : ret_chunk_of((dir_), (step_)))
struct RsRegs { bf16x8 q[8]; };
__device__ __forceinline__ void ret_scan_phase(LAS unsigned char* lds, int tid, int lane, int wave, int vcu, int G, const bf16* Q, const bf16* K, const bf16* V, float* ORf, float* ORb, const float* decay, const int probe = 0) {
    LAS unsigned char* KL = lds;
    LAS unsigned char* VL = lds + 65536;
    LAS bf16* SB = (LAS bf16*)(lds + 65536 + 9216);
    const int l15 = lane & 15, l4 = lane >> 4;
    const int tj = tid >> 2, tc = tid & 3, ti = 16 * wave + l15;
    const int tq = l15 >> 2, tp = l15 & 3;
    int klw[8];
#pragma unroll
    for (int k = 0; k < 8; ++k) klw[k] = (tc >> 1) * 32768 + imgb_off(tj, (tc & 1) * 8 + k);
    int klr[2][2], vlr[2][2];
#pragma unroll
    for (int a = 0; a < 2; ++a)
#pragma unroll
        for (int t = 0; t < 2; ++t) { const int dt = 2 * wave + a;
            klr[a][t] = (dt >> 3) * 32768 + imgb_off(8 * l4 + 4 * t + tq, 2 * (dt & 7) + (tp >> 1)) + 8 * (tp & 1);
            vlr[a][t] = (8 * l4 + 4 * t + tq) * 72 + (16 * a + 4 * tp) * 2; }
    for (int unit = vcu; unit < 256; unit += G) {
        const int b = unit >> 7, h = (unit >> 4) & 7, s = unit & 15;
#pragma unroll 1
        for (int dir = 0; dir < 2; ++dir) {
            const float lg2 = -expf(decay[dir * 8 + h]) * 1.4426950408889634f; const float gC = __builtin_amdgcn_exp2f(lg2 * 128.0f);
            const float zeta = __builtin_amdgcn_exp2f(lg2 * (float)((dir == 0) ? (127 - tj) : tj));
            const float xi = __builtin_amdgcn_exp2f(lg2 * (float)((dir == 0) ? (ti + 1) : (128 - ti)));
            f32x4 Sr[2][2];
#pragma unroll
            for (int a = 0; a < 2; ++a)
#pragma unroll
                for (int e = 0; e < 2; ++e) Sr[a][e] = (f32x4){0.f, 0.f, 0.f, 0.f};
            RsRegs RA, RB; v4u pk[8], pv;
            float* ORd = (dir == 0) ? ORf : ORb;
#define RS_LOAD(R_, step_) do { const size_t r0_ = (size_t)(b * 34 + RCH(dir, (step_))) * 128; \
                const v4u* ks_ = (const v4u*)(K + (r0_ + tj) * DM + h * 256 + tc * 64); _Pragma("unroll") for (int k_ = 0; k_ < 8; ++k_) pk[k_] = ks_[k_]; \
                pv = *(const v4u*)(V + (r0_ + tj) * 4096 + h * 512 + s * 32 + tc * 8); \
                const bf16* qp_ = Q + (r0_ + ti) * DM + h * 256 + 8 * l4; _Pragma("unroll") for (int k_ = 0; k_ < 8; ++k_) R_.q[k_] = *(const bf16x8*)(qp_ + 32 * k_); } while (0)
#define RS_STEP(C_, N_, step_) do { \
                const size_t row0 = (size_t)(b * 34 + RCH(dir, (step_))) * 128; \
                LDS_BARRIER(); \
                _Pragma("unroll") for (int a = 0; a < 2; ++a) _Pragma("unroll") for (int e = 0; e < 2; ++e) { v2u o; o.x = pg8::cvt_pk_bf16(Sr[a][e][0], Sr[a][e][1]); o.y = pg8::cvt_pk_bf16(Sr[a][e][2], Sr[a][e][3]); \
                        *(LAS v2u*)(SB + (16 * e + l15) * 264 + 16 * (2 * wave + a) + 4 * l4) = o; } \
                { _Pragma("unroll") for (int k = 0; k < 8; ++k) *(LAS v4u*)(KL + klw[k]) = pk[k]; \
                  LAS v2u* dv = (LAS v2u*)(VL + tj * 72 + tc * 16); v2u w0, w1; \
                  w0.x = pg8::cvt_pk_bf16(bf_lo(pv.x) * zeta, bf_hi(pv.x) * zeta); w0.y = pg8::cvt_pk_bf16(bf_lo(pv.y) * zeta, bf_hi(pv.y) * zeta); \
                  w1.x = pg8::cvt_pk_bf16(bf_lo(pv.z) * zeta, bf_hi(pv.z) * zeta); w1.y = pg8::cvt_pk_bf16(bf_lo(pv.w) * zeta, bf_hi(pv.w) * zeta); dv[0] = w0; dv[1] = w1; } \
                if ((step_) + 1 < 34 && probe < 2) RS_LOAD(N_, (step_) + 1); \
                LDS_BARRIER(); \
                { f32x4 ac0 = {0.f, 0.f, 0.f, 0.f}, ac1 = ac0; \
                  _Pragma("unroll") for (int kh = 0; kh < 2; ++kh) { bf16x8 sF[2][4]; \
                    _Pragma("unroll") for (int et = 0; et < 2; ++et) _Pragma("unroll") for (int kk = 0; kk < 4; ++kk) sF[et][kk] = *(const LAS bf16x8*)(SB + (16 * et + l15) * 264 + 32 * (4 * kh + kk) + 8 * l4); \
                    _Pragma("unroll") for (int kk = 0; kk < 4; ++kk) { ac0 = mfma16(sF[0][kk], C_.q[4 * kh + kk], ac0); ac1 = mfma16(sF[1][kk], C_.q[4 * kh + kk], ac1); } } \
                  float* op = ORd + (row0 + ti) * 4096 + h * 512 + s * 32 + 4 * l4; \
                  *(f32x4*)op = ac0 * xi; *(f32x4*)(op + 16) = ac1 * xi; } \
                _Pragma("unroll") for (int a = 0; a < 2; ++a) _Pragma("unroll") for (int e = 0; e < 2; ++e) Sr[a][e] = Sr[a][e] * gC; \
                _Pragma("unroll") for (int kk = 0; kk < 4; ++kk) { bf16x8 kF[2], vF[2]; \
                    _Pragma("unroll") for (int a = 0; a < 2; ++a) kF[a] = cat8(lds_tr(KL + klr[a][0] + 8192 * kk), lds_tr(KL + klr[a][1] + 8192 * kk)); \
                    _Pragma("unroll") for (int e = 0; e < 2; ++e) vF[e] = cat8(lds_tr(VL + vlr[e][0] + 2304 * kk), lds_tr(VL + vlr[e][1] + 2304 * kk)); \
                  _Pragma("unroll") for (int a = 0; a < 2; ++a) _Pragma("unroll") for (int e = 0; e < 2; ++e) Sr[a][e] = mfma16(kF[a], vF[e], Sr[a][e]); } \
            } while (0)
            RS_LOAD(RA, 0); if (probe >= 2) { RS_LOAD(RB, 1); }
#pragma unroll 1
            for (int step = 0; step < 34; step += 2) { RS_STEP(RA, RB, step); RS_STEP(RB, RA, step + 1); }
#undef RS_STEP
#undef RS_LOAD
        }
    }
    __syncthreads();
}
__device__ __forceinline__ void ret_gate_phase(int lane, int gw, int NGW, const float* OI, const float* ORf, const float* ORb, const bf16* Gt, bf16* RO) {
    for (int r = gw; r < MALL; r += NGW) {
#pragma unroll
        for (int h = 0; h < 8; ++h) { const size_t off = (size_t)r * 4096 + h * 512 + 4 * lane;
            const f32x4 o0 = *(const f32x4*)(OI + off) + *(const f32x4*)(ORf + off) + *(const f32x4*)(ORb + off), o1 = *(const f32x4*)(OI + off + 256) + *(const f32x4*)(ORf + off + 256) + *(const f32x4*)(ORb + off + 256);
            float ss = (o0.x * o0.x + o0.y * o0.y) + (o0.z * o0.z + o0.w * o0.w) + (o1.x * o1.x + o1.y * o1.y) + (o1.z * o1.z + o1.w * o1.w); ss = wave_sum(ss);
            const float rstd = 1.0f / sqrtf(ss * (1.0f / 512.0f) + EPSN);
            const v2u g0 = *(const v2u*)(Gt + off), g1 = *(const v2u*)(Gt + off + 256);
            v2u w0, w1; w0.x = pg8::cvt_pk_bf16(bf_lo(g0.x) * o0.x * rstd, bf_hi(g0.x) * o0.y * rstd); w0.y = pg8::cvt_pk_bf16(bf_lo(g0.y) * o0.z * rstd, bf_hi(g0.y) * o0.w * rstd);
            w1.x = pg8::cvt_pk_bf16(bf_lo(g1.x) * o1.x * rstd, bf_hi(g1.x) * o1.y * rstd); w1.y = pg8::cvt_pk_bf16(bf_lo(g1.y) * o1.z * rstd, bf_hi(g1.y) * o1.w * rstd);
            *(v2u*)(RO + off) = w0; *(v2u*)(RO + off + 256) = w1; }
    }
}
template <class Epi> __device__ __forceinline__ void run_gemm(int tid, LAS unsigned char* lds, int G, const bf16* A, const bf16* Bt, int N, int K, bool skipctx, const Epi& E, int splitS = 0, int snt = 0) {
    pg8::Gemm g{A, Bt, MALL, N, K}; pg8::Order S; S.init((skipctx || splitS) ? 32 : 34, N / 256, G, (int)blockIdx.x, (skipctx || splitS) ? 1 : 0, K / 64, splitS, snt);
    pg8::gemm_phase<Epi, pg8::Order, true, true>(tid, lds, g, S, E);
}
constexpr int N_PHASES = 2 + 8 * DEPTH + 1;

__global__ void __launch_bounds__(512, 2) fwd_kernel(Args args) {
    extern __shared__ __attribute__((aligned(16))) unsigned char lds_raw[];
    LAS unsigned char* lds = (LAS unsigned char*)lds_raw;
    volatile LAS unsigned* MISC = (volatile LAS unsigned*)(lds + MISC_OFF);
    const int tid0 = threadIdx.x;
    const int G = gridDim.x; const int bx = blockIdx.x; const int vcu = (G % 8 == 0) ? (bx % 8) * (G / 8) + bx / 8 : bx;
    const int NGW = G * 8;
    unsigned char* ws0 = args.ws;
    if (tid0 < 32) MISC[tid0] = 0u;
    LAS unsigned long long* TBL = (LAS unsigned long long*)(lds + MISC_OFF + 256);
    if (tid0 == 0) {
#define TB_ST(i) TBL[i] = (unsigned long long)(uintptr_t)args.in[i];
        TB_ST(0) TB_ST(1) TB_ST(2) TB_ST(3) TB_ST(4) TB_ST(5) TB_ST(6) TB_ST(7) TB_ST(8) TB_ST(9) TB_ST(10) TB_ST(11) TB_ST(12) TB_ST(13) TB_ST(14) TB_ST(15) TB_ST(16) TB_ST(17) TB_ST(18) TB_ST(19) TB_ST(20) TB_ST(21) TB_ST(22) TB_ST(23) TB_ST(24) TB_ST(25)
#undef TB_ST
    }
    __syncthreads();
    const int lo = args.ph_lo, hi = args.ph_hi;
    XcdBarrier bar; bar.bar = (unsigned*)(ws0 + WS_CTL) + CW_BAR; bar.x = 0; bar.st = nullptr;
    if (hi - lo > 1) bar = xcd_barrier_post((unsigned*)(ws0 + WS_CTL) + CW_BAR, MISC + 8);
#ifndef PHMASK
#define PHMASK 0xFFFFFFFFu
#endif
#ifndef DBLMASK
#define DBLMASK 0u
#endif
#define PH_BEGIN(k, kb) if (((PHMASK >> (kb)) & 1u) && lo <= (k) && (k) < hi) { for (int rep_ = 0; rep_ < ((((DBLMASK) >> (kb)) & 1u) ? 2 : 1); ++rep_) { int tid = tid0; asm volatile("" : "+v"(tid)); const int lane = tid & 63, wave = __builtin_amdgcn_readfirstlane(tid >> 6); const int gw = vcu * 8 + wave; \
    size_t zo = 0; asm volatile("" : "+s"(zo)); unsigned char* ws = ws0 + zo; float* X = (float*)(ws + WS_X); bf16* HN = (bf16*)(ws + WS_HN); bf16* HID = (bf16*)(ws + WS_HID); const float* MOD = (const float*)(ws + WS_MOD); unsigned char* act = ws + WS_ACT; const float* modl = MOD + (size_t)layer * 3 * 12288; (void)X; (void)HN; (void)HID; (void)act; (void)modl; (void)lane; (void)gw;
#define PH_END(k)   } if ((k) + 1 < hi) xcd_barrier(bar); }

    int layer = 0;

    PH_BEGIN(0, 0) prologue_phase(TBL, ws, lds, tid, lane, wave, gw, NGW); PH_END(0)
    PH_BEGIN(1, 1) modreduce_phase(TBL, ws, vcu * 512 + tid, G * 512); PH_END(1)

#pragma unroll 1
    for (layer = 0; layer < DEPTH; ++layer) {
        const int kind = layer % 3, jj = layer / 3, pb = 2 + 8 * layer; const bool last = (layer == DEPTH - 1);
        PH_BEGIN(pb + 0, 2) norm_phase(lds, tid, lane, gw, NGW, X, HN, INP(I_NMG) + layer * DM, modl, 0, 2048, false, (const float*)(ws + WS_SLAB), layer > 0 ? 11 : 0, modl - 3 * 12288 + 2 * 12288 + 5 * 2048); PH_END(pb + 0)
        size_t mixAoff, mixWoff; int mixK;
        if (kind == 0) {
#define DA_PTRS bf16 *Qd = (bf16*)act, *Kd = (bf16*)(act + A34), *Vd = (bf16*)(act + 2 * A34); float* OF = (float*)(act + 3 * A34); bf16* DAO = (bf16*)(act + 7 * A34); (void)Qd; (void)Kd; (void)Vd; (void)OF; (void)DAO;
            PH_BEGIN(pb + 1, 3) { DA_PTRS pg8::EpiQkvDa E{Qd, Kd, Vd, (const float*)(ws + WS_RCDA), (const float*)(ws + WS_RSDA)};
                run_gemm(tid, lds, G, HN, (const bf16*)(ws + WS_WQKV + (size_t)jj * 24 * MiB), 6144, 2048, false, E); } PH_END(pb + 1)
            PH_BEGIN(pb + 2, 4) { DA_PTRS da_attn_phase((char*)lds_raw, tid, vcu, G, Qd, Kd, Vd, OF, !last); } PH_END(pb + 2)
            PH_BEGIN(pb + 3, 5) { DA_PTRS da_combine_phase(lane, gw, NGW, OF, DAO, INP(I_DALAM) + jj * 512, INP(I_DASUB) + jj * 256, 0.8f - 0.6f * expf(-0.3f * (float)layer), !last); } PH_END(pb + 3)
            mixAoff = WS_ACT + 7 * A34; mixWoff = WS_WODA + (size_t)jj * 8 * MiB; mixK = 2048;
        } else if (kind == 1) {
#define SG_PTRS bf16 *Ud = (bf16*)act, *Vd = (bf16*)(act + A34), *Gd = (bf16*)(act + 2 * A34); float* VSS = (float*)(ws + WS_VSS); (void)Ud; (void)Vd; (void)Gd; (void)VSS;
            PH_BEGIN(pb + 1, 6) { SG_PTRS pg8::EpiSgIn E{Ud, Vd, VSS}; run_gemm(tid, lds, G, HN, (const bf16*)(ws + WS_WSGI), 4096, 2048, false, E); } PH_END(pb + 1)
            PH_BEGIN(pb + 2, 7) { SG_PTRS sg_phase(lds, tid, lane, wave, vcu, G, Ud, Vd, VSS, INP(I_SGWS), INP(I_SGBS), INP(I_SGVG), Gd); } PH_END(pb + 2)
            mixAoff = WS_ACT + 2 * A34; mixWoff = WS_WSGO; mixK = 2048;
        } else {
#define RT_PTRS bf16 *Qd = (bf16*)act, *Kd = (bf16*)(act + A34), *Vd = (bf16*)(act + 2 * A34), *Gt = (bf16*)(act + 4 * A34); float *OI = (float*)(act + 6 * A34), *ORf = (float*)(act + 10 * A34), *ORb = (float*)(act + 16 * A34); bf16* RO = (bf16*)(act + 14 * A34); (void)Qd; (void)Kd; (void)Vd; (void)Gt; (void)OI; (void)ORf; (void)ORb; (void)RO;
            PH_BEGIN(pb + 1, 8) { RT_PTRS pg8::EpiRet E{Qd, Kd, Vd, Gt, (const float*)(ws + WS_RCRT), (const float*)(ws + WS_RSRT)}; run_gemm(tid, lds, G, HN, (const bf16*)(ws + WS_WRET), 12288, 2048, false, E); } PH_END(pb + 1)
            PH_BEGIN(pb + 2, 9) { RT_PTRS ret_scan_phase(lds, tid, lane, wave, vcu, G, Qd, Kd, Vd, ORf, ORb, INP(I_RDEC));
#if defined(SCANPROBE)
                             ret_scan_phase(lds, tid, lane, wave, vcu, G, Qd, Kd, Vd, (float*)HID, (float*)HID, INP(I_RDEC), SCANPROBE);
#endif
                             for (int rp2 = 0; rp2 < (((DBLMASK >> 15) & 1u) ? 2 : 1); ++rp2) ret_intra_phase(lds, tid, lane, wave, vcu, G, Qd, Kd, Vd, OI, INP(I_RDEC)); } PH_END(pb + 2)
            PH_BEGIN(pb + 3, 10) { RT_PTRS ret_gate_phase(lane, gw, NGW, OI, ORf, ORb, Gt, RO); } PH_END(pb + 3)
            mixAoff = WS_ACT + 14 * A34; mixWoff = WS_WRETO; mixK = 4096;
        }
        PH_BEGIN(pb + 4, 11) { pg8::EpiRes E{X, modl, 2 * 2048, (float*)(ws + WS_SLAB), rep_ == 0 ? 1.0f : 0.0f}; run_gemm(tid, lds, G, (const bf16*)(ws + mixAoff), (const bf16*)(ws + mixWoff), 2048, mixK, last, E, last ? 0 : 8, mixK / 512); } PH_END(pb + 4)
        PH_BEGIN(pb + 5, 2) norm_phase(lds, tid, lane, gw, NGW, X, HN, INP(I_NFG) + layer * DM, modl, 3 * 2048, 4 * 2048, last, (const float*)(ws + WS_SLAB), last ? 0 : 8, modl + 2 * 12288 + 2 * 2048); PH_END(pb + 5)
        PH_BEGIN(pb + 6, 12) { pg8::EpiSwiglu E{HID}; run_gemm(tid, lds, G, HN, (const bf16*)(ws + WS_WGU + (size_t)layer * 44 * MiB), 11264, 2048, last, E); } PH_END(pb + 6)
        PH_BEGIN(pb + 7, 13) { pg8::EpiRes E{X, modl, 5 * 2048, (float*)(ws + WS_SLAB), rep_ == 0 ? 1.0f : 0.0f}; run_gemm(tid, lds, G, HID, (const bf16*)(ws + WS_WD + (size_t)layer * 22 * MiB), 2048, FFH, last, E, last ? 0 : 11, 8); } PH_END(pb + 7)
    }
    PH_BEGIN(N_PHASES - 1, 14) final_norm_phase(lane, gw, NGW, X, args.out, INP(I_FNG)); PH_END(N_PHASES - 1)
#undef PH_BEGIN
#undef PH_END
}

#ifndef ONE_LAUNCH
#define ONE_LAUNCH 1
#endif
extern "C" void kernel_launch(void* const* d_in, const int* in_sizes, int n_in, void* d_out, int out_size, void* d_ws, size_t ws_size, hipStream_t stream) {
    static int grid = 0;
    if (grid == 0) {
        if (n_in != 26 || out_size != NB * SEQ * DM || ws_size < WS_END) { fprintf(stderr, "kernel_launch: unexpected shapes (n_in %d, out %d, ws %zu < %zu)\n", n_in, out_size, ws_size, (size_t)WS_END); grid = -1; return; }
        int dev = 0, cus = 0;
        if (hipGetDevice(&dev) != hipSuccess || hipDeviceGetAttribute(&cus, hipDeviceAttributeMultiprocessorCount, dev) != hipSuccess) { grid = -1; return; }
        if (hipFuncSetAttribute((const void*)fwd_kernel, hipFuncAttributeMaxDynamicSharedMemorySize, LDS_BYTES) != hipSuccess) { fprintf(stderr, "kernel_launch: hipFuncSetAttribute failed\n"); grid = -1; return; }
        grid = cus;
    }
    if (grid < 0) return;
    (void)hipMemsetAsync((char*)d_ws + WS_CTL, 0, CTL_ZERO_BYTES, stream);
    Args a{};
    for (int i = 0; i < 26; ++i) a.in[i] = (const float*)d_in[i];
    a.out = (float*)d_out; a.ws = (unsigned char*)d_ws;
#if ONE_LAUNCH
    a.ph_lo = 0; a.ph_hi = N_PHASES;
    hipLaunchKernelGGL(fwd_kernel, dim3(grid), dim3(512), LDS_BYTES, stream, a);
#else
    for (int p = 0; p < N_PHASES; ++p) {
        if (p == 2 + 8 * 1 + 3) continue;
        a.ph_lo = p; a.ph_hi = p + 1;
        hipLaunchKernelGGL(fwd_kernel, dim3(grid), dim3(512), LDS_BYTES, stream, a);
    }
#endif
}
```

```cpp
#include <hip/hip_runtime.h>
#include <cstdio>
#include <cstdint>

constexpr int DM = 2048, NB = 2, SEQ = 4096, CTXL = 256, TB = SEQ + CTXL  , MALL = NB * TB  ;
constexpr int FFH = 5632, DEPTH = 4;
constexpr float EPSN = 1e-6f;

namespace pg8 {
#define PG8_LAS __attribute__((address_space(3)))
typedef unsigned short bf16_t;
typedef short bf16x8 __attribute__((ext_vector_type(8)));
typedef float f32x4 __attribute__((ext_vector_type(4)));
typedef unsigned u32x4 __attribute__((ext_vector_type(4)));
constexpr int BM = 256, BK = 64, HALF = 128, HTB = HALF * BK * 2  , STAGE_BYTES = 8 * HTB, NXCD = 8, WGM = 8;

__host__ __device__ __forceinline__ int lds_byte(int r, int c) { const int st = (r >> 4) * 2 + (c >> 5), rr = r & 15, cc = c & 31, ob = rr * 64 + cc * 2; return st * 1024 + (ob ^ (((ob >> 9) & 1) << 5)); }
__host__ __device__ __forceinline__ void stage_rc(int b, int& R, int& C) { const int st = b / 1024, sb = b % 1024, swz = sb ^ (((sb >> 9) & 1) << 5); R = (st >> 1) * 16 + swz / 64; C = (st & 1) * 32 + (swz % 64) / 2; }
__host__ __device__ __forceinline__ int perm32(int rho) { const int n = rho >> 4, i = rho & 15; return 8 * (i >> 2) + 4 * n + (i & 3); }

struct Unit { int pm, pn, k0, nt, slab; };
struct Gemm { const bf16_t* A; const bf16_t* Bt; int M, N, K; };


struct Order {
    int nM, nN, nwg, G, c, skip, ntk, S, snt;
    __device__ __forceinline__ void init(int nM_, int nN_, int G_, int c_, int skip_, int ntk_, int S_, int snt_) { nM = nM_; nN = nN_; nwg = nM * nN; G = G_; c = c_; skip = skip_; ntk = ntk_; S = S_; snt = snt_; }
    __device__ __forceinline__ bool next(int i, Unit& u) const {
        const long L = (long)i * G + c;
        if (L >= nwg) {
            const int s = (int)(L - nwg); if (s >= 2 * nN * S) return false;
            const int cu = s / S, part = s - cu * S; u.pm = (cu >= nN) ? 17 : 0; u.pn = (cu >= nN) ? cu - nN : cu; u.k0 = part * snt; u.nt = snt; u.slab = part; return true;
        }
        int wgid = (int)L; { const int q = nwg / NXCD, r = nwg % NXCD, xcd = wgid % NXCD, off = wgid / NXCD; wgid = (xcd < r ? xcd * (q + 1) : r * (q + 1) + (xcd - r) * q) + off; }
        const int nig = WGM * nN, gid = wgid / nig, fm = gid * WGM, gsz = (nM - fm) < WGM ? (nM - fm) : WGM;
        int pm = fm + ((wgid % nig) % gsz); u.pn = (wgid % nig) / gsz;
        if (skip) pm = pm + 1 + (pm >= 16 ? 1 : 0);
        u.pm = pm; u.k0 = 0; u.nt = ntk; u.slab = -1; return true;
    }
    __device__ __forceinline__ void a_ready(const Unit&) const {}
    __device__ __forceinline__ void done(const Unit&) const {}
};

typedef float f32x2_t __attribute__((ext_vector_type(2))); typedef __bf16 bf16x2_t __attribute__((ext_vector_type(2)));
__device__ __forceinline__ unsigned cvt_pk_bf16(float lo, float hi) { f32x2_t v = {lo, hi}; bf16x2_t b = __builtin_convertvector(v, bf16x2_t); return __builtin_bit_cast(unsigned, b); }
typedef float f32x2 __attribute__((ext_vector_type(2)));
__device__ __forceinline__ f32x2 gelu_pk(f32x2 v) {
    const f32x2 av = __builtin_elementwise_abs(v), d = av * 0.2316418882f + 1.0f;
    f32x2 t; t.x = __builtin_amdgcn_rcpf(d.x); t.y = __builtin_amdgcn_rcpf(d.y);
    f32x2 q = t * 0.5307027145f + (-0.7265760135f); q = q * t + 0.7107068705f; q = q * t + (-0.142248368f); q = q * t + 0.127414796f; q = q * t;
    const f32x2 s = (v * v) * (-0.72134752044f);
    f32x2 e; e.x = __builtin_amdgcn_exp2f(s.x); e.y = __builtin_amdgcn_exp2f(s.y);
    const f32x2 m = v * (q * e), r = v - m;
    f32x2 o; o.x = v.x < 0.f ? m.x : r.x; o.y = v.y < 0.f ? m.y : r.y; return o;
}
__device__ __forceinline__ f32x4 gelu4(f32x4 v) { const f32x2 a = gelu_pk((f32x2){v[0], v[1]}), b = gelu_pk((f32x2){v[2], v[3]}); return (f32x4){a.x, a.y, b.x, b.y}; }
__device__ __forceinline__ float silu1(float x) { return x * __builtin_amdgcn_rcpf(1.0f + __builtin_amdgcn_exp2f(-1.4426950408889634f * x)); }
__device__ __forceinline__ f32x4 silu4(f32x4 v) { return (f32x4){silu1(v[0]), silu1(v[1]), silu1(v[2]), silu1(v[3])}; }
__device__ __forceinline__ u32x4 pack8(f32x4 a, f32x4 b) { u32x4 w; w.x = cvt_pk_bf16(a[0], a[1]); w.y = cvt_pk_bf16(a[2], a[3]); w.z = cvt_pk_bf16(b[0], b[1]); w.w = cvt_pk_bf16(b[2], b[3]); return w; }
__device__ __forceinline__ int cvec_of_panel(int pm) { return (pm % 17 == 0) ? 2 : pm / 17; }

struct EpiRes {
    static constexpr bool PERM = false, AFTER_DRAIN = false;
    float* X; const float* modl; int gofs; float* SL; float pscale;
    __device__ __forceinline__ void operator()(const f32x4 (&acc)[2][2][4][2], const Unit& u, int wr, int wc, int fr, int fq) const {
        const int col0 = u.pn * BM + wc * 32 + 4 * fq;
        if (u.slab >= 0) {
            const int crow0 = (u.pm == 17 ? 256 : 0) + wr * 64 + fr; float* base = SL + ((size_t)u.slab * 512 + crow0) * DM + col0;
#pragma unroll
            for (int ai = 0; ai < 2; ++ai)
#pragma unroll
                for (int m = 0; m < 4; ++m) { float* rowp = base + (size_t)(ai * HALF + m * 16) * DM;
#pragma unroll
                    for (int bj = 0; bj < 2; ++bj)
#pragma unroll
                        for (int n = 0; n < 2; ++n) *(f32x4*)(rowp + bj * HALF + n * 16) = acc[ai][bj][m][n]; }
            return;
        }
        const float* gate = modl + cvec_of_panel(u.pm) * 12288 + gofs;
        const int row0 = u.pm * BM + wr * 64 + fr;
        f32x4 gv[2][2];
#pragma unroll
        for (int bj = 0; bj < 2; ++bj)
#pragma unroll
            for (int n = 0; n < 2; ++n) gv[bj][n] = *(const f32x4*)(gate + col0 + bj * HALF + n * 16) * pscale;
#pragma unroll
        for (int ai = 0; ai < 2; ++ai)
#pragma unroll
            for (int m = 0; m < 4; ++m) { float* rowp = X + (size_t)(row0 + ai * HALF + m * 16) * DM + col0;
#pragma unroll
                for (int bj = 0; bj < 2; ++bj)
#pragma unroll
                    for (int n = 0; n < 2; ++n) { f32x4* p = (f32x4*)(rowp + bj * HALF + n * 16); *p = *p + gv[bj][n] * acc[ai][bj][m][n]; } }
    }
};
struct EpiSwiglu {
    static constexpr bool PERM = true, AFTER_DRAIN = false;
    bf16_t* H;
    __device__ __forceinline__ void operator()(const f32x4 (&acc)[2][2][4][2], const Unit& u, int wr, int wc, int fr, int fq) const {
        const int row0 = u.pm * BM + wr * 64 + fr, col0 = u.pn * HALF + wc * 32 + 8 * fq;
#pragma unroll
        for (int ai = 0; ai < 2; ++ai)
#pragma unroll
            for (int m = 0; m < 4; ++m) { bf16_t* rowp = H + (size_t)(row0 + ai * HALF + m * 16) * FFH + col0;
                const f32x4 o0 = silu4(acc[ai][0][m][0]) * acc[ai][1][m][0], o1 = silu4(acc[ai][0][m][1]) * acc[ai][1][m][1];
                *(u32x4*)rowp = pack8(o0, o1); }
    }
};
struct EpiQkvDa {
    static constexpr bool PERM = true, AFTER_DRAIN = false;
    bf16_t *Q, *K, *V; const float *rc, *rs;
    __device__ __forceinline__ void operator()(const f32x4 (&acc)[2][2][4][2], const Unit& u, int wr, int wc, int fr, int fq) const {
        const int row0 = u.pm * BM + wr * 64 + fr;
        if (u.pn >= 16) {
            const int col0 = (u.pn - 16) * BM + wc * 32 + 8 * fq;
#pragma unroll
            for (int ai = 0; ai < 2; ++ai)
#pragma unroll
                for (int m = 0; m < 4; ++m) { bf16_t* rowp = V + (size_t)(row0 + ai * HALF + m * 16) * DM + col0;
#pragma unroll
                    for (int bj = 0; bj < 2; ++bj) *(u32x4*)(rowp + bj * HALF) = pack8(acc[ai][bj][m][0], acc[ai][bj][m][1]); }
        } else {
            bf16_t* dst = (u.pn < 8) ? Q : K; const int h = u.pn & 7;
            const bool lat = (u.pm % 17) != 0; const int tb = (u.pm / 17) * TB + CTXL;
            const int mp = wc >> 1, dd0 = (wc & 1) * 32 + 8 * fq, colb = h * 256 + mp * 128 + dd0;
#pragma unroll
            for (int ai = 0; ai < 2; ++ai)
#pragma unroll
                for (int m = 0; m < 4; ++m) { const int row = row0 + ai * HALF + m * 16;
                    f32x4 o1a = acc[ai][0][m][0], o1b = acc[ai][0][m][1], o2a = acc[ai][1][m][0], o2b = acc[ai][1][m][1];
                    if (lat) { const size_t to = (size_t)(row - tb) * 64 + dd0;
                        const f32x4 ca = *(const f32x4*)(rc + to), cb = *(const f32x4*)(rc + to + 4), sa = *(const f32x4*)(rs + to), sb = *(const f32x4*)(rs + to + 4);
                        const f32x4 x1a = o1a, x1b = o1b, x2a = o2a, x2b = o2b;
                        o1a = x1a * ca - x2a * sa; o2a = x1a * sa + x2a * ca; o1b = x1b * cb - x2b * sb; o2b = x1b * sb + x2b * cb; }
                    bf16_t* rowp = dst + (size_t)row * DM + colb;
                    *(u32x4*)rowp = pack8(o1a, o1b); *(u32x4*)(rowp + 64) = pack8(o2a, o2b); }
        }
    }
};
struct EpiSgIn {
    static constexpr bool PERM = true, AFTER_DRAIN = false;
    bf16_t *U, *V; float* VSS;
    __device__ __forceinline__ void operator()(const f32x4 (&acc)[2][2][4][2], const Unit& u, int wr, int wc, int fr, int fq) const {
        const int row0 = u.pm * BM + wr * 64 + fr; const bool isv = u.pn >= 8;
        bf16_t* dst = isv ? V : U; const int col0 = (u.pn & 7) * BM + wc * 32 + 8 * fq;
#pragma unroll
        for (int ai = 0; ai < 2; ++ai)
#pragma unroll
            for (int m = 0; m < 4; ++m) { const int row = row0 + ai * HALF + m * 16; bf16_t* rowp = dst + (size_t)row * DM + col0; float ss = 0.f;
#pragma unroll
                for (int bj = 0; bj < 2; ++bj) { const f32x4 v0 = gelu4(acc[ai][bj][m][0]), v1 = gelu4(acc[ai][bj][m][1]);
                    ss += (v0[0] * v0[0] + v0[1] * v0[1]) + (v0[2] * v0[2] + v0[3] * v0[3]) + (v1[0] * v1[0] + v1[1] * v1[1]) + (v1[2] * v1[2] + v1[3] * v1[3]);
                    *(u32x4*)(rowp + bj * HALF) = pack8(v0, v1); }
                if (isv) { ss += __shfl_xor(ss, 16); ss += __shfl_xor(ss, 32); if (fq == 0) VSS[(size_t)row * 32 + (u.pn - 8) * 4 + wc] = ss; } }
    }
};
struct EpiRet {
    static constexpr bool PERM = true, AFTER_DRAIN = false;
    bf16_t *Q, *K, *V, *Gt; const float *rc, *rs;
    __device__ __forceinline__ void operator()(const f32x4 (&acc)[2][2][4][2], const Unit& u, int wr, int wc, int fr, int fq) const {
        const int row0 = u.pm * BM + wr * 64 + fr;
        if (u.pn >= 16) {
            const bool isg = u.pn >= 32; bf16_t* dst = isg ? Gt : V; const int col0 = ((u.pn - 16) & 15) * BM + wc * 32 + 8 * fq;
#pragma unroll
            for (int ai = 0; ai < 2; ++ai)
#pragma unroll
                for (int m = 0; m < 4; ++m) { bf16_t* rowp = dst + (size_t)(row0 + ai * HALF + m * 16) * 4096 + col0;
#pragma unroll
                    for (int bj = 0; bj < 2; ++bj) { f32x4 v0 = acc[ai][bj][m][0], v1 = acc[ai][bj][m][1]; if (isg) { v0 = silu4(v0); v1 = silu4(v1); }
                        *(u32x4*)(rowp + bj * HALF) = pack8(v0, v1); } }
        } else {
            const bool isk = u.pn >= 8; bf16_t* dst = isk ? K : Q; const int h = u.pn & 7; const float sc = isk ? 0.0625f : 1.0f;
            const bool lat = (u.pm % 17) != 0; const int tb = (u.pm / 17) * TB + CTXL;
            const int p0 = wc * 32 + 8 * fq, colb = h * 256 + p0;
#pragma unroll
            for (int ai = 0; ai < 2; ++ai)
#pragma unroll
                for (int m = 0; m < 4; ++m) { const int row = row0 + ai * HALF + m * 16;
                    f32x4 o1a = acc[ai][0][m][0], o1b = acc[ai][0][m][1], o2a = acc[ai][1][m][0], o2b = acc[ai][1][m][1];
                    if (lat) { const size_t to = (size_t)(row - tb) * 128 + p0;
                        const f32x4 ca = *(const f32x4*)(rc + to), cb = *(const f32x4*)(rc + to + 4), sa = *(const f32x4*)(rs + to), sb = *(const f32x4*)(rs + to + 4);
                        const f32x4 x1a = o1a, x1b = o1b, x2a = o2a, x2b = o2b;
                        o1a = x1a * ca - x2a * sa; o2a = x1a * sa + x2a * ca; o1b = x1b * cb - x2b * sb; o2b = x1b * sb + x2b * cb; }
                    bf16_t* rowp = dst + (size_t)row * DM + colb;
                    *(u32x4*)rowp = pack8(o1a * sc, o1b * sc); *(u32x4*)(rowp + 128) = pack8(o2a * sc, o2b * sc); }
        }
    }
};

template <class Epi, class Sched, bool ALIGN_EPI = false, bool SP2 = false>
__device__ __forceinline__ void gemm_phase(const int tid, PG8_LAS unsigned char* lds, const Gemm g, const Sched& S, const Epi& E) {
    const int wid = __builtin_amdgcn_readfirstlane(tid >> 6), lane = tid & 63, wr = wid >> 2, wc = wid & 3, fr = lane & 15, fq = lane >> 4;
    const int K = g.K;
    unsigned voffA[2], voffB[2];
#pragma unroll
    for (int i = 0; i < 2; ++i) { int R, C; stage_rc(tid * 16 + i * 8192, R, C); const int Rb = Epi::PERM ? ((R & ~31) + perm32(R & 31)) : R;
        voffA[i] = (unsigned)(R * K + C) * 2u; voffB[i] = (unsigned)(Rb * K + C) * 2u; }
    const size_t kstep = (size_t)(BK * 2);
    const size_t hstep = (size_t)HALF * K * 2;
    const size_t tstep = 2 * hstep;
    const unsigned ldsw = (unsigned)wid * 1024u;
    const int aoff = lds_byte(wr * 64 + fr, fq * 8), boff = lds_byte(wc * 32 + fr, fq * 8);
#define PG8_SA(b, h) (((b) * 2 + (h)) * HTB)
#define PG8_SB(b, h) ((4 + (b) * 2 + (h)) * HTB)
#define PG8_STAGE(bufoff, gbase, voff) do { _Pragma("unroll") for (int _i = 0; _i < 2; ++_i) \
        __builtin_amdgcn_global_load_lds((const unsigned*)((const char*)(gbase) + (voff)[_i]), (PG8_LAS unsigned*)(lds + (bufoff) + ldsw + _i * 8192), 16, 0, 0); } while (0)
#define PG8_LDA(dst, b, h) do { _Pragma("unroll") for (int m = 0; m < 4; ++m) _Pragma("unroll") for (int k = 0; k < 2; ++k) dst[m][k] = *(const PG8_LAS bf16x8*)(lds + PG8_SA(b, h) + aoff + m * 2048 + k * 1024); } while (0)
#define PG8_LDB(dst, b, h) do { _Pragma("unroll") for (int n = 0; n < 2; ++n) _Pragma("unroll") for (int k = 0; k < 2; ++k) dst[n][k] = *(const PG8_LAS bf16x8*)(lds + PG8_SB(b, h) + boff + n * 2048 + k * 1024); } while (0)
#define PG8_MMA(ai, bj, At, Bt) do { __builtin_amdgcn_s_setprio(1); _Pragma("unroll") for (int m = 0; m < 4; ++m) _Pragma("unroll") for (int n = 0; n < 2; ++n) _Pragma("unroll") for (int k = 0; k < 2; ++k) \
        acc[ai][bj][m][n] = __builtin_amdgcn_mfma_f32_16x16x32_bf16(Bt[n][k], At[m][k], acc[ai][bj][m][n], 0, 0, 0); __builtin_amdgcn_s_setprio(0); } while (0)
#define PG8_WAIT_V(n) asm volatile("s_waitcnt vmcnt(" #n ")" ::: "memory")
#define PG8_WAIT_L(n) asm volatile("s_waitcnt lgkmcnt(" #n ")" ::: "memory")
#define PG8_BAR __builtin_amdgcn_s_barrier()
#define PG8_SCHED __builtin_amdgcn_sched_barrier(0)
    Unit cur, nxt; int ui = 0;
    if (!S.next(0, cur)) return;
    f32x4 acc[2][2][4][2];
#pragma unroll
    for (int a = 0; a < 2; ++a)
#pragma unroll
        for (int b = 0; b < 2; ++b)
#pragma unroll
            for (int m = 0; m < 4; ++m)
#pragma unroll
                for (int n = 0; n < 2; ++n) acc[a][b][m][n] = (f32x4){0.f, 0.f, 0.f, 0.f};
    bf16x8 At[4][2], B0[2][2], B1[2][2];
    const char* cA = (const char*)g.A + (size_t)cur.pm * tstep + (size_t)cur.k0 * kstep; const char* cB = (const char*)g.Bt + (size_t)cur.pn * tstep + (size_t)cur.k0 * kstep;
    int nt = cur.nt;
    S.a_ready(cur);
    if constexpr (SP2) {
        PG8_STAGE(PG8_SB(0, 0), cB, voffB); PG8_STAGE(PG8_SB(0, 1), cB + hstep, voffB); PG8_STAGE(PG8_SA(0, 0), cA, voffA); PG8_STAGE(PG8_SA(0, 1), cA + hstep, voffA);
        if (wr == 1) PG8_BAR;
        PG8_WAIT_V(2); PG8_BAR;
        PG8_STAGE(PG8_SB(1, 0), cB + kstep, voffB); PG8_STAGE(PG8_SA(1, 0), cA + kstep, voffA); PG8_STAGE(PG8_SB(1, 1), cB + hstep + kstep, voffB);
        PG8_WAIT_V(6); PG8_BAR;
    } else {
        PG8_STAGE(PG8_SB(0, 0), cB, voffB); PG8_STAGE(PG8_SA(0, 0), cA, voffA); PG8_STAGE(PG8_SB(0, 1), cB + hstep, voffB); PG8_STAGE(PG8_SA(0, 1), cA + hstep, voffA);
        if (wr == 1) PG8_BAR;
        PG8_WAIT_V(4); PG8_BAR;
        PG8_STAGE(PG8_SB(1, 0), cB + kstep, voffB); PG8_STAGE(PG8_SA(1, 0), cA + kstep, voffA); PG8_STAGE(PG8_SB(1, 1), cB + hstep + kstep, voffB);
        PG8_WAIT_V(6); PG8_BAR;
    }
    for (;;) {
        const bool has_next = S.next(ui + 1, nxt);
        const char* nA = has_next ? (const char*)g.A + (size_t)nxt.pm * tstep + (size_t)nxt.k0 * kstep : cA; const char* nB = has_next ? (const char*)g.Bt + (size_t)nxt.pn * tstep + (size_t)nxt.k0 * kstep : cB;
        for (int t = 0; t < nt; t += 2) {
            const bool last = (t == nt - 2);
            const char* a1 = cA + (size_t)(t + 1) * kstep;
            const char* a2 = last ? nA : cA + (size_t)(t + 2) * kstep; const char* b2 = last ? nB : cB + (size_t)(t + 2) * kstep;
            const char* a3 = a2 + kstep; const char* b3 = b2 + kstep;
            if (last && has_next) S.a_ready(nxt);
            if constexpr (SP2) {
            PG8_LDB(B0, 0, 0); PG8_LDB(B1, 0, 1); PG8_SCHED; PG8_LDA(At, 0, 0); PG8_STAGE(PG8_SA(1, 1), a1 + hstep, voffA);
            PG8_WAIT_V(8); PG8_WAIT_L(0); PG8_BAR; PG8_MMA(0, 0, At, B0); PG8_MMA(0, 1, At, B1); PG8_BAR; PG8_SCHED;
            PG8_LDA(At, 0, 1); PG8_STAGE(PG8_SB(0, 0), b2, voffB); PG8_STAGE(PG8_SB(0, 1), b2 + hstep, voffB); PG8_STAGE(PG8_SA(0, 0), a2, voffA);
            PG8_WAIT_V(8); PG8_WAIT_L(0); PG8_BAR; PG8_MMA(1, 0, At, B0); PG8_MMA(1, 1, At, B1); PG8_BAR; PG8_SCHED;
            PG8_LDB(B0, 1, 0); PG8_LDB(B1, 1, 1); PG8_SCHED; PG8_LDA(At, 1, 0); PG8_STAGE(PG8_SA(0, 1), a2 + hstep, voffA);
            PG8_WAIT_V(8); PG8_WAIT_L(0); PG8_BAR; PG8_MMA(0, 0, At, B0); PG8_MMA(0, 1, At, B1); PG8_BAR; PG8_SCHED;
            PG8_LDA(At, 1, 1); PG8_STAGE(PG8_SB(1, 0), b3, voffB); PG8_STAGE(PG8_SB(1, 1), b3 + hstep, voffB); PG8_STAGE(PG8_SA(1, 0), a3, voffA);
            PG8_WAIT_V(8); PG8_WAIT_L(0); PG8_BAR; PG8_MMA(1, 0, At, B0); PG8_MMA(1, 1, At, B1); PG8_BAR; PG8_SCHED;
            } else {
            PG8_LDB(B0, 0, 0); PG8_SCHED; PG8_LDA(At, 0, 0); PG8_STAGE(PG8_SA(1, 1), a1 + hstep, voffA);
            PG8_WAIT_L(8); PG8_BAR; PG8_WAIT_L(0); PG8_MMA(0, 0, At, B0); PG8_BAR; PG8_SCHED;
            PG8_LDB(B1, 0, 1); PG8_STAGE(PG8_SB(0, 0), b2, voffB);
            PG8_BAR; PG8_WAIT_L(0); PG8_MMA(0, 1, At, B1); PG8_BAR;
            PG8_LDA(At, 0, 1); PG8_STAGE(PG8_SA(0, 0), a2, voffA);
            PG8_BAR; PG8_WAIT_L(0); PG8_MMA(1, 0, At, B0); PG8_BAR; PG8_SCHED;
            PG8_STAGE(PG8_SB(0, 1), b2 + hstep, voffB);
            PG8_WAIT_V(6); PG8_BAR; PG8_MMA(1, 1, At, B1); PG8_BAR;
            PG8_LDB(B0, 1, 0); PG8_SCHED; PG8_LDA(At, 1, 0); PG8_STAGE(PG8_SA(0, 1), a2 + hstep, voffA);
            PG8_WAIT_L(8); PG8_BAR; PG8_WAIT_L(0); PG8_MMA(0, 0, At, B0); PG8_BAR; PG8_SCHED;
            PG8_LDB(B1, 1, 1); PG8_STAGE(PG8_SB(1, 0), b3, voffB);
            PG8_BAR; PG8_WAIT_L(0); PG8_MMA(0, 1, At, B1); PG8_BAR;
            PG8_LDA(At, 1, 1); PG8_STAGE(PG8_SA(1, 0), a3, voffA);
            PG8_BAR; PG8_WAIT_L(0); PG8_MMA(1, 0, At, B0); PG8_BAR; PG8_SCHED;
            PG8_STAGE(PG8_SB(1, 1), b3 + hstep, voffB);
            PG8_WAIT_V(6); PG8_BAR; PG8_MMA(1, 1, At, B1); PG8_BAR;
            }
        }
        if constexpr (ALIGN_EPI) { if (wr == 0) PG8_BAR; }
        if constexpr (!Epi::AFTER_DRAIN) { E(acc, cur, wr, wc, fr, fq); S.done(cur); }
        if (!has_next) break;
#pragma unroll
        for (int a = 0; a < 2; ++a)
#pragma unroll
            for (int b = 0; b < 2; ++b)
#pragma unroll
                for (int m = 0; m < 4; ++m)
#pragma unroll
                    for (int n = 0; n < 2; ++n) acc[a][b][m][n] = (f32x4){0.f, 0.f, 0.f, 0.f};
        cur = nxt; cA = nA; cB = nB; nt = nxt.nt; ++ui;
        if constexpr (ALIGN_EPI) { if (wr == 1) PG8_BAR; }
    }
    PG8_WAIT_V(0);
    if constexpr (!ALIGN_EPI) { if (wr == 0) PG8_BAR; }
    PG8_BAR;
    if constexpr (Epi::AFTER_DRAIN) { E.fused(acc, cur, wr, wc, fr, fq, lds, wid, lane); S.done(cur); }
#undef PG8_SA
#undef PG8_SB
#undef PG8_STAGE
#undef PG8_LDA
#undef PG8_LDB
#undef PG8_MMA
#undef PG8_WAIT_V
#undef PG8_WAIT_L
#undef PG8_BAR
#undef PG8_SCHED
}
}
namespace att {
typedef unsigned short bf16;
constexpr int   D = 128, NW = 8, QBLK = 32, KVBLK = 64;
constexpr float SCALE = 0.088388347648318440f;
constexpr float THR = 8.f;
#ifndef ATT_SDEPTH
#define ATT_SDEPTH 1
#endif
constexpr int SDEPTH = ATT_SDEPTH;
constexpr size_t SHM_V = KVBLK * D * 2, SHM_K = KVBLK * D * 2, SHM_ATTN = 2 * SHM_V + 2 * SHM_K + NW * 64 * 4;
using bf16x8 = __attribute__((ext_vector_type(8))) short;
using s16x4  = __attribute__((ext_vector_type(4))) short;
using f32x16 = __attribute__((ext_vector_type(16))) float;
using f32x8  = __attribute__((ext_vector_type(8))) float;
using u32x4  = __attribute__((ext_vector_type(4))) unsigned;
#define KSWZ(row, colB) ((row) * 256 + ((colB) ^ (((row) & 7) << 4)))
#define SBAR() __builtin_amdgcn_sched_barrier(0)
__device__ __forceinline__ int crow(int r, int hi) { return (r & 3) + 8 * (r >> 2) + 4 * hi; }
__device__ __forceinline__ unsigned cvtpk(float lo, float hi) {
  unsigned r; asm volatile("v_cvt_pk_bf16_f32 %0, %1, %2" : "=v"(r) : "v"(lo), "v"(hi)); return r;
}
__device__ __forceinline__ void partialSM(f32x16& p0, f32x16& p1, float& m_reg, float& mn, float& alpha) {
  constexpr float C = SCALE * 1.4426950408889634f;
  float pmax = p0[0]; for (int r = 1; r < 16; ++r) pmax = fmaxf(pmax, p0[r]); for (int r = 0; r < 16; ++r) pmax = fmaxf(pmax, p1[r]);
  { auto rr = __builtin_amdgcn_permlane32_swap(__float_as_uint(pmax), __float_as_uint(pmax), false, false);
    pmax = fmaxf(__uint_as_float(rr[0]), __uint_as_float(rr[1])); }
  if (__builtin_expect(__all(pmax - m_reg <= THR / SCALE), 1)) { mn = m_reg; alpha = 1.f; }
  else { mn = fmaxf(m_reg, pmax); alpha = __builtin_amdgcn_exp2f((m_reg - mn) * C); m_reg = mn; }
  float mnC = -mn * C;
  for (int r = 0; r < 16; ++r) p0[r] = fmaf(p0[r], C, mnC); for (int r = 0; r < 16; ++r) p1[r] = fmaf(p1[r], C, mnC);
  for (int r = 0; r < 16; ++r) p0[r] = __builtin_amdgcn_exp2f(p0[r]);
}
__device__ __forceinline__ void finishSM(f32x16& p0, f32x16& p1, float alpha, float& l_reg, bf16x8& pa0, bf16x8& pa1, bf16x8& pa2, bf16x8& pa3) {
  for (int r = 0; r < 16; ++r) p1[r] = __builtin_amdgcn_exp2f(p1[r]);
  float ps = 0; for (int r = 0; r < 16; ++r) ps += p0[r]; for (int r = 0; r < 16; ++r) ps += p1[r];
  { auto rr = __builtin_amdgcn_permlane32_swap(__float_as_uint(ps), __float_as_uint(ps), false, false);
    ps = __uint_as_float(rr[0]) + __uint_as_float(rr[1]); }
  l_reg = l_reg * alpha + ps;
#define PK4(P, BASE, OUT) do { unsigned a0 = cvtpk(P[BASE + 0], P[BASE + 1]), a1 = cvtpk(P[BASE + 2], P[BASE + 3]);   \
    unsigned b0 = cvtpk(P[BASE + 4], P[BASE + 5]), b1 = cvtpk(P[BASE + 6], P[BASE + 7]);                              \
    auto r0 = __builtin_amdgcn_permlane32_swap(a0, b0, false, false); auto r1 = __builtin_amdgcn_permlane32_swap(a1, b1, false, false); \
    u32x4 w = {r0[0], r1[0], r0[1], r1[1]}; OUT = *reinterpret_cast<bf16x8*>(&w); } while (0)
  PK4(p0, 0, pa0); PK4(p0, 8, pa1); PK4(p1, 0, pa2); PK4(p1, 8, pa3);
#undef PK4
}
__device__ __forceinline__ void qkt(f32x16& p0, f32x16& p1, const bf16* Ks, const bf16x8* qr, int r32, int hi) {
  p0 = f32x16{}; p1 = f32x16{};
  for (int d0 = 0; d0 < 8; ++d0) { int cb = (d0 * 16 + hi * 8) * 2;
    bf16x8 b0 = *reinterpret_cast<const bf16x8*>((const char*)Ks + KSWZ(r32, cb));
    bf16x8 b1 = *reinterpret_cast<const bf16x8*>((const char*)Ks + KSWZ(32 + r32, cb));
    p0 = __builtin_amdgcn_mfma_f32_32x32x16_bf16(b0, qr[d0], p0, 0, 0, 0);
    p1 = __builtin_amdgcn_mfma_f32_32x32x16_bf16(b1, qr[d0], p1, 0, 0, 0); }
}
__device__ __forceinline__ int v_st(int k, int c) { const int kk = (k & ~0xC) | ((k & 4) << 1) | ((k & 8) >> 1); return ((kk >> 3) * 4 + (c >> 5)) * 512 + ((kk & 7) * 32 + (c & 31)) * 2; }
__device__ __forceinline__ int v_rd_base(int lane) { return ((lane & 3) << 3) | (((lane >> 2) & 3) << 6) | (((lane >> 4) & 1) << 5) | (((lane >> 5) & 1) << 8); }
constexpr int v_rd_off(int d0, int ks, int half) { return d0 * 512 + ks * 4096 + half * 2048; }
template <int OFF> __device__ __forceinline__ s16x4 tr_read(int vb) {
  s16x4 r; asm volatile("ds_read_b64_tr_b16 %0, %1 offset:%2" : "=&v"(r) : "v"(vb), "i"(OFF) : "memory"); return r;
}
template <int D0> __device__ __forceinline__ void pv_one(f32x16& od, int vb, bf16x8 pa0, bf16x8 pa1, bf16x8 pa2, bf16x8 pa3) {
  const s16x4 l0 = tr_read<v_rd_off(D0, 0, 0)>(vb), h0 = tr_read<v_rd_off(D0, 0, 1)>(vb), l1 = tr_read<v_rd_off(D0, 1, 0)>(vb), h1 = tr_read<v_rd_off(D0, 1, 1)>(vb);
  const s16x4 l2 = tr_read<v_rd_off(D0, 2, 0)>(vb), h2 = tr_read<v_rd_off(D0, 2, 1)>(vb), l3 = tr_read<v_rd_off(D0, 3, 0)>(vb), h3 = tr_read<v_rd_off(D0, 3, 1)>(vb);
  asm volatile("s_waitcnt lgkmcnt(0)" ::: "memory"); SBAR();
#define PK(L, H) (bf16x8){L[0], L[1], L[2], L[3], H[0], H[1], H[2], H[3]}
  od = __builtin_amdgcn_mfma_f32_32x32x16_bf16(pa0, PK(l0, h0), od, 0, 0, 0);
  od = __builtin_amdgcn_mfma_f32_32x32x16_bf16(pa1, PK(l1, h1), od, 0, 0, 0);
  od = __builtin_amdgcn_mfma_f32_32x32x16_bf16(pa2, PK(l2, h2), od, 0, 0, 0);
  od = __builtin_amdgcn_mfma_f32_32x32x16_bf16(pa3, PK(l3, h3), od, 0, 0, 0);
#undef PK
}
__device__ __forceinline__ void pv_d0(f32x16* o, int vb, bf16x8 pa0, bf16x8 pa1, bf16x8 pa2, bf16x8 pa3) {
  pv_one<0>(o[0], vb, pa0, pa1, pa2, pa3); pv_one<1>(o[1], vb, pa0, pa1, pa2, pa3); pv_one<2>(o[2], vb, pa0, pa1, pa2, pa3); pv_one<3>(o[3], vb, pa0, pa1, pa2, pa3);
}

template <int LDQ, int LDK, int LDO>
__device__ __forceinline__ void attn_dense_body(const int tid, const bf16* __restrict__ Qb, const bf16* __restrict__ Kh, const bf16* __restrict__ Vh,
                                                float* __restrict__ Ob, int seq, char* lds) {

  const int wid = tid >> 6, lane = tid & 63, r32 = lane & 31, hi = lane >> 5;
  bf16* V_lds = (bf16*)lds; bf16* K_lds = (bf16*)(lds + 2 * SHM_V);
  float* ws = (float*)(lds + 2 * SHM_V + 2 * SHM_K) + wid * 64; float* li_l = ws; float* al_l = ws + 32;
  float m_reg = -1e30f, l_reg = 0; f32x16 o[4] = {}; bf16x8 qr[8];
  const bf16* Qw = Qb + (long)(wid * QBLK + r32) * LDQ + hi * 8;
#pragma unroll
  for (int d0 = 0; d0 < 8; ++d0) qr[d0] = *reinterpret_cast<const bf16x8*>(Qw + d0 * 16);
  const int sr = tid >> 4, sc = (tid & 15) * 8, vst0 = v_st(sr, sc), vst1 = v_st(32 + sr, sc);
  const int vb0 = (int)(uintptr_t)V_lds + v_rd_base(lane);
  struct { bf16x8 vs0, vs1, ks0, ks1; } sr_[SDEPTH];
#define SLOAD(i, k0) do { sr_[i].vs0 = (*reinterpret_cast<const bf16x8*>(&Vh[(long)((k0) + sr) * LDK + sc])); sr_[i].vs1 = (*reinterpret_cast<const bf16x8*>(&Vh[(long)((k0) + 32 + sr) * LDK + sc])); \
    sr_[i].ks0 = (*reinterpret_cast<const bf16x8*>(&Kh[(long)((k0) + sr) * LDK + sc])); sr_[i].ks1 = (*reinterpret_cast<const bf16x8*>(&Kh[(long)((k0) + 32 + sr) * LDK + sc])); } while (0)
#define SWRITE(b, i) do { *(bf16x8*)((char*)V_lds + (b) * SHM_V + vst0) = sr_[i].vs0;          \
    *(bf16x8*)((char*)V_lds + (b) * SHM_V + vst1) = sr_[i].vs1; int kc = sc * 2;               \
    *(bf16x8*)((char*)K_lds + (b) * SHM_K + KSWZ(sr, kc)) = sr_[i].ks0;                       \
    *(bf16x8*)((char*)K_lds + (b) * SHM_K + KSWZ(32 + sr, kc)) = sr_[i].ks1; } while (0)
#define SWAIT() do { if constexpr (SDEPTH == 2) asm volatile("s_waitcnt vmcnt(4)" ::: "memory"); else asm volatile("s_waitcnt vmcnt(0)" ::: "memory"); } while (0)
#define RESC(a) do { if (__any((a) < 1.f)) { if (hi == 0) al_l[r32] = (a); asm volatile("s_waitcnt lgkmcnt(0)" ::: "memory"); \
    for (int d = 0; d < 4; ++d) for (int r = 0; r < 16; ++r) o[d][r] *= al_l[crow(r, hi)]; } } while (0)
  f32x16 pA0, pA1, pB0, pB1; float mnA, mnB, alA, alB; bf16x8 pa0, pa1, pa2, pa3; const int NT = seq / KVBLK;
  constexpr int SE = 0, SO = SDEPTH - 1;
  SLOAD(SE, 0); asm volatile("s_waitcnt vmcnt(0)" ::: "memory"); SWRITE(0, SE); __syncthreads();
  qkt(pA0, pA1, K_lds, qr, r32, hi); partialSM(pA0, pA1, m_reg, mnA, alA);
  SLOAD(SO, KVBLK); if constexpr (SDEPTH == 2) { if (2 < NT) SLOAD(SE, 2 * KVBLK); }
  SWAIT(); SWRITE(1, SO); __syncthreads();
  for (int j = 1; j + 1 < NT; j += 2) {
    SBAR(); qkt(pB0, pB1, (bf16*)((char*)K_lds + SHM_K), qr, r32, hi);
    finishSM(pA0, pA1, alA, l_reg, pa0, pa1, pa2, pa3); SBAR();
    SLOAD(SO, (j + SDEPTH) * KVBLK); SBAR();
    pv_d0(o, vb0, pa0, pa1, pa2, pa3); partialSM(pB0, pB1, m_reg, mnB, alB);
    __syncthreads(); SWAIT(); SWRITE(0, SE);
    RESC(alB); __syncthreads();
    SBAR(); qkt(pA0, pA1, K_lds, qr, r32, hi);
    finishSM(pB0, pB1, alB, l_reg, pa0, pa1, pa2, pa3); SBAR();
    if (SDEPTH == 1 || j + 3 < NT) SLOAD(SE, (j + 1 + SDEPTH) * KVBLK); SBAR();
    pv_d0(o, vb0 + (int)SHM_V, pa0, pa1, pa2, pa3); partialSM(pA0, pA1, m_reg, mnA, alA);
    __syncthreads(); SWAIT(); SWRITE(1, SO);
    RESC(alA); __syncthreads();
  }
  SBAR(); qkt(pB0, pB1, (bf16*)((char*)K_lds + SHM_K), qr, r32, hi);
  finishSM(pA0, pA1, alA, l_reg, pa0, pa1, pa2, pa3); SBAR();
  pv_d0(o, vb0, pa0, pa1, pa2, pa3); partialSM(pB0, pB1, m_reg, mnB, alB);
  __syncthreads(); RESC(alB);
  finishSM(pB0, pB1, alB, l_reg, pa0, pa1, pa2, pa3); SBAR();
  pv_d0(o, vb0 + (int)SHM_V, pa0, pa1, pa2, pa3);
  if (hi == 0) li_l[r32] = l_reg; asm volatile("s_waitcnt lgkmcnt(0)" ::: "memory");
  float rli[16];
#pragma unroll
  for (int r = 0; r < 16; ++r) rli[r] = __builtin_amdgcn_rcpf(li_l[crow(r, hi)]);
  float* Ow = Ob + (long)(wid * QBLK) * LDO;
#pragma unroll
  for (int r = 0; r < 16; ++r) { int orow = crow(r, hi);
    for (int d0 = 0; d0 < 4; ++d0) Ow[(long)orow * LDO + d0 * 32 + r32] = o[d0][r] * rli[r]; }
#undef SLOAD
#undef SWRITE
#undef SWAIT
#undef RESC
}
}
#define GAS __attribute__((address_space(1)))
#define LAS __attribute__((address_space(3)))
typedef unsigned short bf16;
typedef unsigned v4u __attribute__((ext_vector_type(4)));
typedef unsigned v2u __attribute__((ext_vector_type(2)));
typedef float f32x4 __attribute__((ext_vector_type(4)));
typedef short bf16x8 __attribute__((ext_vector_type(8)));
typedef GAS unsigned gu32;
#define RLX_AGENT __ATOMIC_RELAXED, __HIP_MEMORY_SCOPE_AGENT
#define LDS_WAIT() asm volatile("s_waitcnt lgkmcnt(0)" ::: "memory")
#define LDS_BARRIER() do { asm volatile("s_waitcnt lgkmcnt(0)" ::: "memory"); __builtin_amdgcn_s_barrier(); asm volatile("" ::: "memory"); } while (0)
#define VM_WAIT() asm volatile("s_waitcnt vmcnt(0)" ::: "memory")
__device__ __forceinline__ unsigned f2bf(float f) { unsigned u = __builtin_bit_cast(unsigned, f); return (u + 0x7fffu + ((u >> 16) & 1u)) >> 16; }
__device__ __forceinline__ unsigned pk2(float lo, float hi) { return f2bf(lo) | (f2bf(hi) << 16); }
__device__ __forceinline__ float bf_lo(unsigned w) { return __builtin_bit_cast(float, w << 16); }
__device__ __forceinline__ float bf_hi(unsigned w) { return __builtin_bit_cast(float, w & 0xffff0000u); }
__device__ __forceinline__ float wave_sum(float v) {
#pragma unroll
    for (int o = 1; o < 64; o <<= 1) v += __shfl_xor(v, o);
    return v;
}
__device__ __forceinline__ f32x4 mfma16(bf16x8 a, bf16x8 b, f32x4 c) { return __builtin_amdgcn_mfma_f32_16x16x32_bf16(a, b, c, 0, 0, 0); }

__device__ __forceinline__ const float* in_ptr(const LAS unsigned long long* TBL, int i) {
    const unsigned long long v = TBL[i]; const unsigned lo = __builtin_amdgcn_readfirstlane((unsigned)v), hi = __builtin_amdgcn_readfirstlane((unsigned)(v >> 32));
    return (const float*)(const GAS float*)(uintptr_t)(((unsigned long long)hi << 32) | lo);
}
#define INP(i) in_ptr(TBL, i)

typedef short v4i16_t __attribute__((ext_vector_type(4)));
__device__ __forceinline__ v4i16_t lds_tr(const LAS unsigned char* p) { return __builtin_amdgcn_ds_read_tr16_b64_v4i16((LAS v4i16_t*)p); }
__device__ __forceinline__ bf16x8 cat8(v4i16_t lo, v4i16_t hi) { return __builtin_shufflevector(lo, hi, 0, 1, 2, 3, 4, 5, 6, 7); }
__device__ __forceinline__ int imgb_off(int row, int ch) { return 256 * row + 16 * (ch ^ (((row & 3) << 2) | ((row >> 2) & 3))); }

#define XB_TMO      128
#define XB_XCNT(j)  (256  + 64 * (j))
#define XB_XSUB(j)  (1280 + 64 * (j))
#define XB_XGEN(j)  (2304 + 64 * (j))
#define XB_TOP      3328
#define XB_TOPGEN   3392
#define XCD_BAR_WORDS 3456
#define XB_SPIN_CAP (1u << 18)

__device__ __forceinline__ unsigned xb_ld(unsigned* p)              { return __hip_atomic_load(p, __ATOMIC_RELAXED, __HIP_MEMORY_SCOPE_AGENT); }
__device__ __forceinline__ unsigned xb_add(unsigned* p, unsigned v) { return __hip_atomic_fetch_add(p, v, __ATOMIC_RELAXED, __HIP_MEMORY_SCOPE_AGENT); }
__device__ __forceinline__ unsigned xb_xcc_id() { return (unsigned)__builtin_amdgcn_s_getreg((3 << 11) | 20) & 0xFu; }
#define XB_SPIN(cond, bar) do { unsigned _sp = 0; while (cond) { __builtin_amdgcn_s_sleep(1); \
    if ((++_sp & 255u) == 0u) { if (xb_ld(&(bar)[XB_TMO])) break; if (_sp > XB_SPIN_CAP) { atomicAdd(&(bar)[XB_TMO], 1u); break; } } } } while (0)

struct XcdBarrier {
    unsigned* bar; unsigned x;
    volatile LAS unsigned* st;
};

__device__ __forceinline__ XcdBarrier xcd_barrier_post(unsigned* bar, volatile LAS unsigned* st) {
    XcdBarrier b; b.bar = bar; b.x = xb_xcc_id(); b.st = st;
    if (threadIdx.x == 0) (void)xb_add(&bar[XB_XCNT(b.x)], 1u);
    return b;
}
__device__ __forceinline__ void xcd_barrier_complete(unsigned* bar, unsigned x, unsigned& nloc, unsigned& nx) {
    const unsigned G = gridDim.x * gridDim.y * gridDim.z;
    unsigned sum, cnt, mine, sp = 0u;
    for (;;) {
        sum = 0u; cnt = 0u; mine = 0u;
#pragma unroll
        for (unsigned j = 0; j < 16; ++j) { const unsigned c = xb_ld(&bar[XB_XCNT(j)]); sum += c; cnt += (c > 0u) ? 1u : 0u; mine = (j == x) ? c : mine; }
        if (sum == G) break;
        __builtin_amdgcn_s_sleep(1);
        if ((++sp & 255u) == 0u) { if (xb_ld(&bar[XB_TMO])) break; if (sp > XB_SPIN_CAP) { atomicAdd(&bar[XB_TMO], 1u); break; } }
    }
    nloc = mine > 0u ? mine : 1u; nx = cnt > 0u ? cnt : 1u;
}

__device__ __forceinline__ void xcd_barrier(const XcdBarrier& b) {
    asm volatile("s_waitcnt vmcnt(0)" ::: "memory");
    __syncthreads();
    if (threadIdx.x == 0) {
        unsigned* bar = b.bar;
        __builtin_amdgcn_s_waitcnt(0);
        unsigned nloc = b.st[0], nx = b.st[1];
        unsigned bx_ = b.x; asm volatile("" : "+s"(bx_));
        if (nloc == 0u) { xcd_barrier_complete(bar, bx_, nloc, nx); b.st[0] = nloc; b.st[1] = nx; }
        const unsigned old = xb_add(&bar[XB_XSUB(bx_)], 1u);
        const unsigned gen = old / nloc;
        if (old + 1u == (gen + 1u) * nloc) {
            __builtin_amdgcn_fence(__ATOMIC_RELEASE, "agent");
            asm volatile("s_waitcnt vmcnt(0)" ::: "memory");
            const unsigned og = xb_add(&bar[XB_TOP], 1u);
            const unsigned tg = og / nx;
            if (og + 1u == (tg + 1u) * nx) xb_add(&bar[XB_TOPGEN], 1u);
            else XB_SPIN(xb_ld(&bar[XB_TOPGEN]) == tg, bar);
            __builtin_amdgcn_fence(__ATOMIC_ACQUIRE, "agent");
            xb_add(&bar[XB_XGEN(bx_)], 1u);
            asm volatile("s_waitcnt vmcnt(0)" ::: "memory");
        } else {
            XB_SPIN(xb_ld(&bar[XB_XGEN(bx_)]) == gen, bar);
            __builtin_amdgcn_fence(__ATOMIC_ACQUIRE, "agent");
            asm volatile("s_waitcnt vmcnt(0)" ::: "memory");
        }
    }
    __syncthreads();
}
constexpr size_t MiB = 1u << 20;
constexpr size_t WS_CTL = 0, CTL_ZERO_BYTES = 1 * MiB;
constexpr size_t WS_MODP = 1 * MiB;
constexpr size_t WS_MOD = 6 * MiB;
constexpr size_t WS_RCDA = 7 * MiB, WS_RSDA = 8 * MiB;
constexpr size_t WS_RCRT = 9 * MiB, WS_RSRT = 11 * MiB;
constexpr size_t WS_VSS = 13 * MiB;
constexpr size_t WS_WQKV = 16 * MiB;
constexpr size_t WS_WODA = 64 * MiB;
constexpr size_t WS_WSGI = 80 * MiB, WS_WSGO = 96 * MiB;
constexpr size_t WS_WRET = 104 * MiB, WS_WRETO = 152 * MiB;
constexpr size_t WS_WGU = 168 * MiB;
constexpr size_t WS_WD = 344 * MiB;
constexpr size_t WS_X = 432 * MiB;
constexpr size_t WS_HN = 500 * MiB;
constexpr size_t WS_HID = 534 * MiB;
constexpr size_t WS_ACT = 628 * MiB;
constexpr size_t WS_SLAB = 1308 * MiB;
constexpr size_t WS_END = 1352 * MiB;
constexpr size_t A34 = 34 * MiB;
constexpr int CW_BAR = 4096;

constexpr int LDS_BYTES = 147456, MISC_OFF = 139264;

struct Args { const float* in[26]; float* out; unsigned char* ws; int ph_lo, ph_hi; };
enum { I_X = 0, I_C, I_CTX, I_CCTX, I_ADAW, I_ADAB, I_NMG, I_NFG, I_WGU, I_WD, I_DAQKV, I_DAO, I_DALAM, I_DASUB, I_SGIN, I_SGVG, I_SGWS, I_SGBS, I_SGOUT,
       I_RQ, I_RK, I_RV, I_RG, I_RO, I_RDEC, I_FNG };

struct TJob { const float* W; bf16* WT; int K, N, kind, row_off; };
__device__ __forceinline__ int dest_row(int kind, int n0) {
    if (kind == 1) {
        if (n0 >= 4096) return n0;
        const int sec = n0 >> 11, r = n0 & 2047, h = r >> 8, m = (r >> 7) & 1, hf = (r >> 6) & 1;
        return sec * 2048 + h * 256 + hf * 128 + m * 64;
    }
    if (kind == 2) {
        if (n0 < FFH) return (n0 >> 7) * 256 + (n0 & 127);
        const int n1 = n0 - FFH; return (n1 >> 7) * 256 + 128 + (n1 & 127);
    }
    return n0;
}
__device__ __forceinline__ void transpose_item(const TJob& J, int item, LAS bf16* scr, int lane) {
    const int nblk = J.N >> 6, kb = item / nblk, nb = item - kb * nblk, k0 = kb << 6, n0 = nb << 6;
    const int drow = J.row_off + dest_row(J.kind, n0);
    const float* src = J.W + (size_t)(k0 + (lane >> 4)) * J.N + n0 + 4 * (lane & 15);
    f32x4 v[16];
#pragma unroll
    for (int i = 0; i < 16; ++i) v[i] = *(const f32x4*)(src + (size_t)(4 * i) * J.N);
#pragma unroll
    for (int i = 0; i < 16; ++i) { const int kk = (lane >> 4) + 4 * i; LAS unsigned* d = (LAS unsigned*)(scr + kk * 66 + 4 * (lane & 15));
        d[0] = pg8::cvt_pk_bf16(v[i].x, v[i].y); d[1] = pg8::cvt_pk_bf16(v[i].z, v[i].w); }
    LDS_WAIT();
    const int c = lane & 7;
#pragma unroll
    for (int j = 0; j < 8; ++j) { const int n = (lane >> 3) + 8 * j; const LAS bf16* s = scr + (8 * c) * 66 + n;
        v4u o; o.x = (unsigned)s[0] | ((unsigned)s[66] << 16); o.y = (unsigned)s[132] | ((unsigned)s[198] << 16);
        o.z = (unsigned)s[264] | ((unsigned)s[330] << 16); o.w = (unsigned)s[396] | ((unsigned)s[462] << 16);
        *(v4u*)(J.WT + (size_t)(drow + n) * J.K + k0 + 8 * c) = o; }
    LDS_WAIT();
}
__device__ __forceinline__ void gemv_item(const float* ada_w, float* MODP, const LAS float* SC, int it, int lane) {
    const int l = it / 384, rem = it - l * 384, ks = rem / 48, nc = rem - ks * 48;
    const float* Wp = ada_w + ((size_t)l * 2048 + ks * 256) * 12288 + nc * 256 + 4 * lane;
    f32x4 a0 = {0.f, 0.f, 0.f, 0.f}, a1 = a0, a2 = a0;
    for (int k = 0; k < 256; k += 16) {
        f32x4 w[16];
#pragma unroll
        for (int i = 0; i < 16; ++i) w[i] = *(const f32x4*)(Wp + (size_t)(k + i) * 12288);
#pragma unroll
        for (int i = 0; i < 16; ++i) { const int kk = ks * 256 + k + i; const float s0 = SC[kk], s1 = SC[2048 + kk], s2 = SC[4096 + kk];
            a0 += w[i] * s0; a1 += w[i] * s1; a2 += w[i] * s2; }
    }
    float* o = MODP + ((size_t)(ks * 4 + l) * 3) * 12288 + nc * 256 + 4 * lane;
    *(f32x4*)o = a0; *(f32x4*)(o + 12288) = a1; *(f32x4*)(o + 24576) = a2;
}

__device__ __forceinline__ void prologue_phase(const LAS unsigned long long* TBL, unsigned char* ws, LAS unsigned char* lds, int tid, int lane, int wave, int gw, int NGW) {
    LAS float* SC = (LAS float*)(lds + 69632);
    for (int idx = tid; idx < 3 * 2048; idx += 512) { const float cv = (idx < 4096) ? INP(I_C)[idx] : INP(I_CCTX)[idx - 4096]; SC[idx] = cv / (1.0f + __expf(-cv)); }
    __syncthreads();
    LAS bf16* scr = (LAS bf16*)(lds + wave * 8448);
    constexpr int N_GEMV = 4 * 8 * 48, N_T = 53248, N_XC = MALL, N_ROPE = SEQ, N_ALL = N_GEMV + N_T + N_XC + N_ROPE;
    for (int it = gw; it < N_ALL; it += NGW) {
        if (it < N_GEMV) { gemv_item(INP(I_ADAW), (float*)(ws + WS_MODP), SC, it, lane); continue; }
        int r = it - N_GEMV;
        if (r < N_T) {
            TJob J; bool found = false;
#define TJ(src_, dst_, K_, N_, kind_, ro_) { const int n_ = ((K_) >> 6) * ((N_) >> 6); if (!found) { if (r < n_) { J.W = (src_); J.WT = (bf16*)(dst_); J.K = (K_); J.N = (N_); J.kind = (kind_); J.row_off = (ro_); found = true; } else r -= n_; } }
            TJ(INP(I_WGU), ws + WS_WGU, 2048, 11264, 2, 0)
            TJ(INP(I_WGU) + (size_t)1 * 2048 * 11264, ws + WS_WGU + 44 * MiB, 2048, 11264, 2, 0)
            TJ(INP(I_WGU) + (size_t)2 * 2048 * 11264, ws + WS_WGU + 88 * MiB, 2048, 11264, 2, 0)
            TJ(INP(I_WGU) + (size_t)3 * 2048 * 11264, ws + WS_WGU + 132 * MiB, 2048, 11264, 2, 0)
            TJ(INP(I_WD), ws + WS_WD, 5632, 2048, 0, 0)
            TJ(INP(I_WD) + (size_t)1 * 5632 * 2048, ws + WS_WD + 22 * MiB, 5632, 2048, 0, 0)
            TJ(INP(I_WD) + (size_t)2 * 5632 * 2048, ws + WS_WD + 44 * MiB, 5632, 2048, 0, 0)
            TJ(INP(I_WD) + (size_t)3 * 5632 * 2048, ws + WS_WD + 66 * MiB, 5632, 2048, 0, 0)
            TJ(INP(I_DAQKV), ws + WS_WQKV, 2048, 6144, 1, 0)
            TJ(INP(I_DAQKV) + (size_t)2048 * 6144, ws + WS_WQKV + 24 * MiB, 2048, 6144, 1, 0)
            TJ(INP(I_DAO), ws + WS_WODA, 2048, 2048, 0, 0)
            TJ(INP(I_DAO) + (size_t)2048 * 2048, ws + WS_WODA + 8 * MiB, 2048, 2048, 0, 0)
            TJ(INP(I_SGIN), ws + WS_WSGI, 2048, 4096, 0, 0)
            TJ(INP(I_SGOUT), ws + WS_WSGO, 2048, 2048, 0, 0)
            TJ(INP(I_RQ), ws + WS_WRET, 2048, 2048, 0, 0)
            TJ(INP(I_RK), ws + WS_WRET, 2048, 2048, 0, 2048)
            TJ(INP(I_RV), ws + WS_WRET, 2048, 4096, 0, 4096)
            TJ(INP(I_RG), ws + WS_WRET, 2048, 4096, 0, 8192)
            TJ(INP(I_RO), ws + WS_WRETO, 4096, 2048, 0, 0)
#undef TJ
            if (found) transpose_item(J, r, scr, lane);
            continue;
        }
        r -= N_T;
        if (r < N_XC) {
            const int b = r / TB, i = r - b * TB;
            const float* src = (i < CTXL) ? INP(I_CTX) + (size_t)(b * CTXL + i) * DM : INP(I_X) + (size_t)(b * SEQ + i - CTXL) * DM;
            float* dst = (float*)(ws + WS_X) + (size_t)r * DM;
#pragma unroll
            for (int j = 0; j < 8; ++j) *(f32x4*)(dst + 256 * j + 4 * lane) = *(const f32x4*)(src + 256 * j + 4 * lane);
            continue;
        }
        r -= N_XC;
        {
            const float rowp = (float)(r >> 6), colp = (float)(r & 63);
            { const int f = lane & 31; const float inv = __builtin_amdgcn_exp2f(-(float)f * (13.287712379549449f / 32.0f)); const float ang = ((lane < 32) ? rowp : colp) * inv;
              const float rev = ang * 0.15915494309189535f, fr = rev - floorf(rev);
              ((float*)(ws + WS_RCDA))[(size_t)r * 64 + lane] = __builtin_amdgcn_cosf(fr); ((float*)(ws + WS_RSDA))[(size_t)r * 64 + lane] = __builtin_amdgcn_sinf(fr); }
#pragma unroll
            for (int q = 0; q < 2; ++q) { const int j = lane + 64 * q, f = j & 63; const float inv = __builtin_amdgcn_exp2f(-(float)f * (13.287712379549449f / 64.0f)); const float ang = ((j < 64) ? rowp : colp) * inv;
              const float rev = ang * 0.15915494309189535f, fr = rev - floorf(rev);
              ((float*)(ws + WS_RCRT))[(size_t)r * 128 + j] = __builtin_amdgcn_cosf(fr); ((float*)(ws + WS_RSRT))[(size_t)r * 128 + j] = __builtin_amdgcn_sinf(fr); }
        }
    }
    __syncthreads();
}
__device__ __forceinline__ void modreduce_phase(const LAS unsigned long long* TBL, unsigned char* ws, int gtid, int gthreads) {
    const float* MODP = (const float*)(ws + WS_MODP); float* MOD = (float*)(ws + WS_MOD);
    for (int idx = gtid; idx < 36864; idx += gthreads) {
        const int e = idx * 4, l = e / 36864, rem = e - l * 36864, j = rem / 12288, n = rem - j * 12288;
        f32x4 s = *(const f32x4*)(INP(I_ADAB) + l * 12288 + n);
#pragma unroll
        for (int ks = 0; ks < 8; ++ks) s += *(const f32x4*)(MODP + ((size_t)(ks * 4 + l) * 3 + j) * 12288 + n);
        *(f32x4*)(MOD + e) = s;
    }
}
__device__ __forceinline__ void norm_phase(LAS unsigned char* lds, int tid, int lane, int gw, int NGW, float* X, bf16* HN, const float* gain, const float* modl, int sofs, int cofs, bool skipctx, const float* SL, int nslab, const float* sgate) {
    LAS float* A = (LAS float*)lds; LAS float* Bv = A + 3 * 2048;
    for (int idx = tid; idx < 3 * 2048; idx += 512) { const int j = idx >> 11, c = idx & 2047; A[idx] = gain[c] * (1.0f + modl[j * 12288 + cofs + c]); Bv[idx] = modl[j * 12288 + sofs + c]; }
    __syncthreads();
    for (int r = gw; r < MALL; r += NGW) {
        const int b = r / TB, i = r - b * TB, jv = (i < CTXL) ? 2 : b;
        if (skipctx && jv == 2) continue;
        float* xr = X + (size_t)r * DM + 4 * lane;
        f32x4 v[8]; float ss = 0.f;
#pragma unroll
        for (int j = 0; j < 8; ++j) v[j] = *(const f32x4*)(xr + 256 * j);
        if (jv == 2 && nslab > 0) {
            const float* sl = SL + (size_t)(b * CTXL + i) * DM + 4 * lane;
#pragma unroll
            for (int j = 0; j < 8; ++j) { f32x4 t = {0.f, 0.f, 0.f, 0.f};
                for (int s = 0; s < nslab; ++s) t += *(const f32x4*)(sl + (size_t)s * 512 * DM + 256 * j);
                v[j] += t * *(const f32x4*)(sgate + 256 * j + 4 * lane); *(f32x4*)(xr + 256 * j) = v[j]; }
        }
#pragma unroll
        for (int j = 0; j < 8; ++j) ss += (v[j].x * v[j].x + v[j].y * v[j].y) + (v[j].z * v[j].z + v[j].w * v[j].w);
        ss = wave_sum(ss); const float rstd = 1.0f / sqrtf(ss * (1.0f / 2048.0f) + EPSN);
        const LAS float* Aj = A + jv * 2048 + 4 * lane; const LAS float* Bj = Bv + jv * 2048 + 4 * lane;
        bf16* hr = HN + (size_t)r * DM + 4 * lane;
#pragma unroll
        for (int j = 0; j < 8; ++j) { const f32x4 aa = *(const LAS f32x4*)(Aj + 256 * j), bb = *(const LAS f32x4*)(Bj + 256 * j); const f32x4 h = v[j] * rstd * aa + bb;
            v2u o; o.x = pg8::cvt_pk_bf16(h.x, h.y); o.y = pg8::cvt_pk_bf16(h.z, h.w); *(v2u*)(hr + 256 * j) = o; }
    }
    __syncthreads();
}
__device__ __forceinline__ void final_norm_phase(int lane, int gw, int NGW, const float* X, float* out, const float* gain) {
    for (int r = gw; r < NB * SEQ; r += NGW) {
        const int b = r / SEQ, t = r - b * SEQ; const float* xr = X + (size_t)(b * TB + CTXL + t) * DM + 4 * lane;
        f32x4 v[8]; float ss = 0.f;
#pragma unroll
        for (int j = 0; j < 8; ++j) { v[j] = *(const f32x4*)(xr + 256 * j); ss += (v[j].x * v[j].x + v[j].y * v[j].y) + (v[j].z * v[j].z + v[j].w * v[j].w); }
        ss = wave_sum(ss); const float rstd = 1.0f / sqrtf(ss * (1.0f / 2048.0f) + EPSN);
        float* orow = out + (size_t)r * DM + 4 * lane;
#pragma unroll
        for (int j = 0; j < 8; ++j) *(f32x4*)(orow + 256 * j) = v[j] * rstd * *(const f32x4*)(gain + 256 * j + 4 * lane);
    }
}
__device__ __forceinline__ void da_attn_phase(char* ldsg, int tid, int vcu, int G, const bf16* Q, const bf16* K, const bf16* V, float* OF, bool need_ctx) {
    const int nlat = 1024, total = nlat + (need_ctx ? 64 : 0);
#pragma unroll 1
    for (int u = vcu; u < total; u += G) {
        int head, qb; if (u < nlat) { head = u >> 4; qb = 1 + (u & 15); } else { head = u - nlat; qb = 0; }
        const int b = head >> 5, h = (head >> 2) & 7, m = (head >> 1) & 1, vh = head & 1;
        const size_t rb = (size_t)b * TB;
        const bf16* Qb = Q + (rb + (size_t)qb * 256) * DM + h * 256 + m * 128;
        const bf16* Kh = K + rb * DM + h * 256 + m * 128;
        const bf16* Vh = V + rb * DM + h * 256 + vh * 128;
        float* Ob = OF + (rb + (size_t)qb * 256) * 4096 + (h * 2 + m) * 256 + vh * 128;
        att::attn_dense_body<DM, DM, 4096>(tid, Qb, Kh, Vh, Ob, qb == 0 ? CTXL : TB, ldsg);
        __syncthreads();
    }
}
__device__ __forceinline__ void da_combine_phase(int lane, int gw, int NGW, const float* OF, bf16* DAO, const float* lamv, const float* subg, float lambda_init, bool need_ctx) {
    float sa = lamv[lane] * lamv[128 + lane] + lamv[64 + lane] * lamv[192 + lane], sb = lamv[256 + lane] * lamv[384 + lane] + lamv[320 + lane] * lamv[448 + lane];
    sa = wave_sum(sa); sb = wave_sum(sb);
    const float lam = expf(sa) - expf(sb) + lambda_init, post = 1.0f - lambda_init;
    const f32x4 g4 = *(const f32x4*)(subg + 4 * lane) * post;
    for (int r = gw; r < MALL; r += NGW) {
        const int i = r % TB; if (!need_ctx && i < CTXL) continue;
        const float* orow = OF + (size_t)r * 4096 + 4 * lane; bf16* drow = DAO + (size_t)r * DM + 4 * lane;
#pragma unroll
        for (int h = 0; h < 8; ++h) {
            const f32x4 o1 = *(const f32x4*)(orow + h * 512), o2 = *(const f32x4*)(orow + h * 512 + 256); const f32x4 o = o1 - o2 * lam;
            float ss = (o.x * o.x + o.y * o.y) + (o.z * o.z + o.w * o.w); ss = wave_sum(ss);
            const float rstd = 1.0f / sqrtf(ss * (1.0f / 256.0f) + EPSN); const f32x4 y = o * rstd * g4;
            v2u w; w.x = pg8::cvt_pk_bf16(y.x, y.y); w.y = pg8::cvt_pk_bf16(y.z, y.w); *(v2u*)(drow + h * 256) = w;
        }
    }
}
__device__ __forceinline__ void sg_phase(LAS unsigned char* lds, int tid, int lane, int wave, int vcu, int G, const bf16* U, const bf16* V, const float* VSS,
                                         const float* w_s, const float* b_s, const float* v_gain, bf16* Gout) {
    LAS bf16* vL = (LAS bf16*)lds;
    LAS bf16* wL = (LAS bf16*)(lds + 33280);
    LAS float* rs = (LAS float*)(lds + 68096);
    const int l15 = lane & 15, l4 = lane >> 4;
    for (int unit = vcu; unit < 68 * 16; unit += G) {
        const int ci = unit >> 4, g = unit & 15, row0 = ci * 128;
        LDS_BARRIER();
        if (tid < 128) { const float* p = VSS + (size_t)(row0 + tid) * 32; float s = 0.f;
#pragma unroll
            for (int k = 0; k < 32; ++k) s += p[k];
            rs[tid] = 1.0f / sqrtf(s * (1.0f / 2048.0f) + EPSN); }
        { const bf16* src = V + (size_t)(row0 + (tid >> 4)) * DM + g * 128 + (tid & 15) * 8;
#pragma unroll
          for (int k = 0; k < 4; ++k) { const v4u x = *(const v4u*)(src + (size_t)(32 * k) * DM); LAS unsigned* d = (LAS unsigned*)(vL + ((tid >> 4) + 32 * k) * 130 + (tid & 15) * 8);
              d[0] = x.x; d[1] = x.y; d[2] = x.z; d[3] = x.w; } }
        LDS_BARRIER();
        { const float* src = w_s + ((size_t)g * 128 + (tid >> 5)) * 128 + (tid & 31) * 4; const f32x4 r4 = *(const LAS f32x4*)(rs + (tid & 31) * 4);
#pragma unroll
          for (int k = 0; k < 8; ++k) { const f32x4 a = *(const f32x4*)(src + (size_t)(16 * k) * 128) * r4;
              v2u o; o.x = pg8::cvt_pk_bf16(a.x, a.y); o.y = pg8::cvt_pk_bf16(a.z, a.w); *(LAS v2u*)(wL + ((tid >> 5) + 16 * k) * 136 + (tid & 31) * 4) = o; } }
        LDS_BARRIER();
        bf16x8 aF[4];
#pragma unroll
        for (int kk = 0; kk < 4; ++kk) { const LAS bf16* s = vL + (32 * kk + 8 * l4) * 130 + 16 * wave + l15;
#pragma unroll
            for (int jj = 0; jj < 8; ++jj) aF[kk][jj] = (short)s[jj * 130]; }
        f32x4 acc[8];
#pragma unroll
        for (int pt = 0; pt < 8; ++pt) { acc[pt] = (f32x4){0.f, 0.f, 0.f, 0.f};
#pragma unroll
            for (int kk = 0; kk < 4; ++kk) { const bf16x8 bF = *(const LAS bf16x8*)(wL + (16 * pt + l15) * 136 + 32 * kk + 8 * l4); acc[pt] = mfma16(aF[kk], bF, acc[pt]); } }
        const int col = g * 128 + 16 * wave + 4 * l4; const f32x4 gn = *(const f32x4*)(v_gain + col);
        LDS_BARRIER();
        LAS float* OT = (LAS float*)lds;
#pragma unroll
        for (int pt = 0; pt < 8; ++pt) { const int p = 16 * pt + l15; const float bs = b_s[g * 128 + p]; *(LAS f32x4*)(OT + p * 132 + 16 * wave + 4 * l4) = gn * acc[pt] + bs; }
        LDS_BARRIER();
#pragma unroll
        for (int k = 0; k < 4; ++k) { const int p = (tid >> 4) + 32 * k, ch = tid & 15; const size_t off = (size_t)(row0 + p) * DM + g * 128 + ch * 8;
            const f32x4 y0 = *(const LAS f32x4*)(OT + p * 132 + ch * 8), y1 = *(const LAS f32x4*)(OT + p * 132 + ch * 8 + 4); const v4u uu = *(const v4u*)(U + off);
            v4u o; o.x = pg8::cvt_pk_bf16(bf_lo(uu.x) * y0.x, bf_hi(uu.x) * y0.y); o.y = pg8::cvt_pk_bf16(bf_lo(uu.y) * y0.z, bf_hi(uu.y) * y0.w);
            o.z = pg8::cvt_pk_bf16(bf_lo(uu.z) * y1.x, bf_hi(uu.z) * y1.y); o.w = pg8::cvt_pk_bf16(bf_lo(uu.w) * y1.z, bf_hi(uu.w) * y1.w); *(v4u*)(Gout + off) = o; }
    }
    __syncthreads();
}
__device__ __forceinline__ int ret_chunk_of(int dir, int step) { return (dir == 0) ? step : (step < 2 ? 1 - step : 35 - step); }
__device__ __forceinline__ void ret_state_phase(LAS unsigned char* lds, int tid, int lane, int wave, int vcu, int G, const bf16* K, const bf16* V, bf16* SBUF, const float* decay) {
    LAS unsigned char* KL = lds;
    LAS unsigned char* VL = lds + 65536;
    LAS bf16* SL = (LAS bf16*)(lds + 65536 + 18432);
    const int l15 = lane & 15, l4 = lane >> 4;
    const int tq = l15 >> 2, tp = l15 & 3;
    const int kch = tid & 31, krow0 = tid >> 5, vch = tid & 7, vrow0 = tid >> 3;
    int klw[8];
#pragma unroll
    for (int k = 0; k < 8; ++k) klw[k] = (kch >> 4) * 32768 + imgb_off(krow0 + 16 * k, kch & 15);
    int klr[2][2], vlr[2];
#pragma unroll
    for (int t = 0; t < 2; ++t) { vlr[t] = (8 * l4 + 4 * t + tq) * 144 + 8 * tp;
#pragma unroll
        for (int a = 0; a < 2; ++a) { const int dt = 2 * wave + a; klr[a][t] = (dt >> 3) * 32768 + imgb_off(8 * l4 + 4 * t + tq, 2 * (dt & 7) + (tp >> 1)) + 8 * (tp & 1); } }
    for (int unit = vcu; unit < 256; unit += G) {
        const int b = unit >> 7, h = (unit >> 4) & 7, dir = (unit >> 3) & 1, s = unit & 7;
        const float lg2 = -expf(decay[dir * 8 + h]) * 1.4426950408889634f; const float gC = __builtin_amdgcn_exp2f(lg2 * 128.0f);
        float zeta[2];
#pragma unroll
        for (int q = 0; q < 2; ++q) { const int j = vrow0 + 64 * q; zeta[q] = __builtin_amdgcn_exp2f(lg2 * (float)((dir == 0) ? (127 - j) : j)); }
        f32x4 Sr[2][4];
#pragma unroll
        for (int a = 0; a < 2; ++a)
#pragma unroll
            for (int e = 0; e < 4; ++e) Sr[a][e] = (f32x4){0.f, 0.f, 0.f, 0.f};
        bf16* sb0 = SBUF + ((size_t)((dir * 2 + b) * 8 + h) * 34) * (512 * 256) + (size_t)(64 * s + krow0) * 256 + kch * 8;
        v4u pk[8], pv[2];
#define RS_LOAD(step_) do { const size_t r0_ = (size_t)(b * 34 + ret_chunk_of(dir, (step_))) * 128; \
            const bf16* ks_ = K + (r0_ + krow0) * DM + h * 256 + kch * 8; _Pragma("unroll") for (int k_ = 0; k_ < 8; ++k_) pk[k_] = *(const v4u*)(ks_ + (size_t)(16 * k_) * DM); \
            const bf16* vs_ = V + (r0_ + vrow0) * 4096 + h * 512 + s * 64 + vch * 8; pv[0] = *(const v4u*)vs_; pv[1] = *(const v4u*)(vs_ + (size_t)64 * 4096); } while (0)
        RS_LOAD(0);
#pragma unroll 1
        for (int step = 0; step < 34; ++step) {
            const int c = ret_chunk_of(dir, step);
            LDS_BARRIER();
            { _Pragma("unroll") for (int k = 0; k < 8; ++k) *(LAS v4u*)(KL + klw[k]) = pk[k];
#pragma unroll
              for (int q = 0; q < 2; ++q) { const float z = zeta[q]; v4u w; w.x = pg8::cvt_pk_bf16(bf_lo(pv[q].x) * z, bf_hi(pv[q].x) * z); w.y = pg8::cvt_pk_bf16(bf_lo(pv[q].y) * z, bf_hi(pv[q].y) * z);
                  w.z = pg8::cvt_pk_bf16(bf_lo(pv[q].z) * z, bf_hi(pv[q].z) * z); w.w = pg8::cvt_pk_bf16(bf_lo(pv[q].w) * z, bf_hi(pv[q].w) * z); *(LAS v4u*)(VL + (vrow0 + 64 * q) * 144 + vch * 16) = w; } }
            if (step + 1 < 34) RS_LOAD(step + 1);
#pragma unroll
            for (int a = 0; a < 2; ++a)
#pragma unroll
                for (int e = 0; e < 4; ++e) { v2u o; o.x = pg8::cvt_pk_bf16(Sr[a][e][0], Sr[a][e][1]); o.y = pg8::cvt_pk_bf16(Sr[a][e][2], Sr[a][e][3]); *(LAS v2u*)(SL + (16 * e + l15) * 264 + 32 * wave + 16 * a + 4 * l4) = o; }
            LDS_BARRIER();
            { bf16* sp = sb0 + (size_t)c * (512 * 256);
#pragma unroll
              for (int k = 0; k < 4; ++k) *(v4u*)(sp + (size_t)(16 * k) * 256) = *(const LAS v4u*)(SL + (krow0 + 16 * k) * 264 + kch * 8); }
#pragma unroll
            for (int a = 0; a < 2; ++a)
#pragma unroll
                for (int e = 0; e < 4; ++e) Sr[a][e] = Sr[a][e] * gC;
#pragma unroll
            for (int kk = 0; kk < 4; ++kk) { bf16x8 kF[2], vF[4];
#pragma unroll
                for (int a = 0; a < 2; ++a) kF[a] = cat8(lds_tr(KL + klr[a][0] + 8192 * kk), lds_tr(KL + klr[a][1] + 8192 * kk));
#pragma unroll
                for (int e = 0; e < 4; ++e) vF[e] = cat8(lds_tr(VL + vlr[0] + 4608 * kk + 32 * e), lds_tr(VL + vlr[1] + 4608 * kk + 32 * e));
#pragma unroll
                for (int a = 0; a < 2; ++a)
#pragma unroll
                    for (int e = 0; e < 4; ++e) Sr[a][e] = mfma16(kF[a], vF[e], Sr[a][e]); }
        }
#undef RS_LOAD
    }
    __syncthreads();
}
__device__ __forceinline__ void ret_out_phase(LAS unsigned char* lds, int tid, int lane, int wave, int vcu, int G, const bf16* Q, const bf16* K, const bf16* V, const bf16* SBUF, const bf16* Gt, bf16* RO, const float* decay) {
    LAS bf16* PL = (LAS bf16*)lds;
    LAS bf16* QL = (LAS bf16*)(lds + 34816);
    LAS unsigned char* VT = lds + 102400;
    LAS float* RED = (LAS float*)lds;
    const int l15 = lane & 15, l4 = lane >> 4, tq = l15 >> 2, tp = l15 & 3;
    int vtr[2];
#pragma unroll
    for (int t = 0; t < 2; ++t) vtr[t] = imgb_off(8 * l4 + 4 * t + tq, 2 * wave + (tp >> 1)) + 8 * (tp & 1);
    for (int unit = vcu; unit < 68 * 8; unit += G) {
        const int bc = unit >> 3, h = unit & 7, b = bc / 34, c = bc - b * 34; const size_t row0 = (size_t)bc * 128;
        const float lgf = -expf(decay[h]) * 1.4426950408889634f, lgb = -expf(decay[8 + h]) * 1.4426950408889634f;
        LDS_BARRIER();
        { bf16x8 qF[8]; const bf16* qp = Q + (row0 + 16 * wave + l15) * DM + h * 256 + 8 * l4;
#pragma unroll
          for (int kk = 0; kk < 8; ++kk) qF[kk] = *(const bf16x8*)(qp + 32 * kk);
          const int i = 16 * wave + l15;
#pragma unroll 1
          for (int jt = 0; jt < 8; ++jt) { const bf16* kp = K + (row0 + 16 * jt + l15) * DM + h * 256 + 8 * l4; f32x4 acc = {0.f, 0.f, 0.f, 0.f};
#pragma unroll
              for (int kk = 0; kk < 8; ++kk) { const bf16x8 kF = *(const bf16x8*)(kp + 32 * kk); acc = mfma16(kF, qF[kk], acc); }
              float pv[4];
#pragma unroll
              for (int r = 0; r < 4; ++r) { const int j = 16 * jt + 4 * l4 + r; const int dd = i - j;
                  const float w = (dd > 0) ? __builtin_amdgcn_exp2f(lgf * (float)dd) : (dd < 0) ? __builtin_amdgcn_exp2f(lgb * (float)(-dd)) : 2.0f; pv[r] = acc[r] * w; }
              v2u o; o.x = pg8::cvt_pk_bf16(pv[0], pv[1]); o.y = pg8::cvt_pk_bf16(pv[2], pv[3]); *(LAS v2u*)(PL + i * 136 + 16 * jt + 4 * l4) = o; } }
        f32x4 acc[4][8]; const f32x4 zero4 = {0.f, 0.f, 0.f, 0.f};
#pragma unroll
        for (int ec = 0; ec < 4; ++ec) {
            LDS_BARRIER();
            { const bf16* src = V + (row0 + (tid >> 4)) * 4096 + h * 512 + ec * 128 + (tid & 15) * 8;
#pragma unroll
              for (int k = 0; k < 4; ++k) *(LAS v4u*)(VT + imgb_off((tid >> 4) + 32 * k, tid & 15)) = *(const v4u*)(src + (size_t)(32 * k) * 4096); }
            LDS_BARRIER();
#pragma unroll
            for (int kk = 0; kk < 4; ++kk) { const bf16x8 aF = cat8(lds_tr(VT + vtr[0] + 8192 * kk), lds_tr(VT + vtr[1] + 8192 * kk));
#pragma unroll
                for (int it = 0; it < 8; ++it) { const bf16x8 bF = *(const LAS bf16x8*)(PL + (16 * it + l15) * 136 + 32 * kk + 8 * l4); acc[ec][it] = mfma16(aF, bF, kk == 0 ? zero4 : acc[ec][it]); } }
        }
#pragma unroll 1
        for (int dir = 0; dir < 2; ++dir) {
            const float lg = dir ? lgb : lgf;
            LDS_BARRIER();
            { const bf16* src = Q + (row0 + (tid >> 5)) * DM + h * 256 + (tid & 31) * 8;
#pragma unroll 4
              for (int k = 0; k < 8; ++k) { const int i = (tid >> 5) + 16 * k; const float xi = __builtin_amdgcn_exp2f(lg * (float)(dir ? (128 - i) : (i + 1)));
                  const v4u x = *(const v4u*)(src + (size_t)(16 * k) * DM); v4u w; w.x = pg8::cvt_pk_bf16(bf_lo(x.x) * xi, bf_hi(x.x) * xi); w.y = pg8::cvt_pk_bf16(bf_lo(x.y) * xi, bf_hi(x.y) * xi);
                  w.z = pg8::cvt_pk_bf16(bf_lo(x.z) * xi, bf_hi(x.z) * xi); w.w = pg8::cvt_pk_bf16(bf_lo(x.w) * xi, bf_hi(x.w) * xi); *(LAS v4u*)(QL + i * 264 + (tid & 31) * 8) = w; } }
            LDS_BARRIER();
            const bf16* sp = SBUF + ((size_t)((dir * 2 + b) * 8 + h) * 34 + c) * (512 * 256) + (size_t)(16 * wave + l15) * 256 + 8 * l4;
#pragma unroll 1
            for (int kk = 0; kk < 8; ++kk) {
#pragma unroll
              for (int eh = 0; eh < 2; ++eh) { bf16x8 aS[2];
#pragma unroll
                for (int e2 = 0; e2 < 2; ++e2) aS[e2] = *(const bf16x8*)(sp + (size_t)(128 * (2 * eh + e2)) * 256 + 32 * kk);
#pragma unroll
                for (int ih = 0; ih < 2; ++ih) { bf16x8 bQ[4];
#pragma unroll
                    for (int i4 = 0; i4 < 4; ++i4) bQ[i4] = *(const LAS bf16x8*)(QL + (16 * (4 * ih + i4) + l15) * 264 + 32 * kk + 8 * l4);
#pragma unroll
                    for (int e2 = 0; e2 < 2; ++e2)
#pragma unroll
                        for (int i4 = 0; i4 < 4; ++i4) acc[2 * eh + e2][4 * ih + i4] = mfma16(aS[e2], bQ[i4], acc[2 * eh + e2][4 * ih + i4]); } } }
        }
        LDS_BARRIER();
#pragma unroll
        for (int it = 0; it < 8; ++it) { float ss = 0.f;
#pragma unroll
            for (int ec = 0; ec < 4; ++ec) { const f32x4 v = acc[ec][it]; ss += (v.x * v.x + v.y * v.y) + (v.z * v.z + v.w * v.w); }
            ss += __shfl_xor(ss, 16); ss += __shfl_xor(ss, 32);
            if (l4 == 0) RED[wave * 128 + 16 * it + l15] = ss; }
        LDS_BARRIER();
        LAS float* RSTD = RED + 1024;
        if (tid < 128) { float ss = 0.f;
#pragma unroll
            for (int w = 0; w < 8; ++w) ss += RED[w * 128 + tid];
            RSTD[tid] = 1.0f / sqrtf(ss * (1.0f / 512.0f) + EPSN); }
        LAS float* OT = (LAS float*)(lds + 8192);
#pragma unroll
        for (int ec = 0; ec < 4; ++ec) {
            LDS_BARRIER();
#pragma unroll
            for (int it = 0; it < 8; ++it) *(LAS f32x4*)(OT + (16 * it + l15) * 132 + 16 * wave + 4 * l4) = acc[ec][it] * RSTD[16 * it + l15];
            LDS_BARRIER();
#pragma unroll
            for (int k = 0; k < 4; ++k) { const int i = (tid >> 4) + 32 * k, ch = tid & 15; const size_t off = (row0 + i) * 4096 + h * 512 + ec * 128 + ch * 8;
                const f32x4 y0 = *(const LAS f32x4*)(OT + i * 132 + ch * 8), y1 = *(const LAS f32x4*)(OT + i * 132 + ch * 8 + 4); const v4u g = *(const v4u*)(Gt + off);
                v4u o; o.x = pg8::cvt_pk_bf16(bf_lo(g.x) * y0.x, bf_hi(g.x) * y0.y); o.y = pg8::cvt_pk_bf16(bf_lo(g.y) * y0.z, bf_hi(g.y) * y0.w);
                o.z = pg8::cvt_pk_bf16(bf_lo(g.z) * y1.x, bf_hi(g.z) * y1.y); o.w = pg8::cvt_pk_bf16(bf_lo(g.w) * y1.z, bf_hi(g.w) * y1.w); *(v4u*)(RO + off) = o; }
        }
    }
    __syncthreads();
}
template <class Epi> __device__ __forceinline__ void run_gemm(int tid, LAS unsigned char* lds, int G, const bf16* A, const bf16* Bt, int N, int K, bool skipctx, const Epi& E, int splitS = 0, int snt = 0) {
    pg8::Gemm g{A, Bt, MALL, N, K}; pg8::Order S; S.init((skipctx || splitS) ? 32 : 34, N / 256, G, (int)blockIdx.x, (skipctx || splitS) ? 1 : 0, K / 64, splitS, snt);
    pg8::gemm_phase<Epi, pg8::Order, true, true>(tid, lds, g, S, E);
}
constexpr int N_PHASES = 2 + 8 * DEPTH + 1;

__global__ void __launch_bounds__(512, 2) fwd_kernel(Args args) {
    extern __shared__ __attribute__((aligned(16))) unsigned char lds_raw[];
    LAS unsigned char* lds = (LAS unsigned char*)lds_raw;
    volatile LAS unsigned* MISC = (volatile LAS unsigned*)(lds + MISC_OFF);
    const int tid0 = threadIdx.x;
    const int G = gridDim.x; const int bx = blockIdx.x; const int vcu = (G % 8 == 0) ? (bx % 8) * (G / 8) + bx / 8 : bx;
    const int NGW = G * 8;
    unsigned char* ws0 = args.ws;
    if (tid0 < 32) MISC[tid0] = 0u;
    LAS unsigned long long* TBL = (LAS unsigned long long*)(lds + MISC_OFF + 256);
    if (tid0 == 0) {
#define TB_ST(i) TBL[i] = (unsigned long long)(uintptr_t)args.in[i];
        TB_ST(0) TB_ST(1) TB_ST(2) TB_ST(3) TB_ST(4) TB_ST(5) TB_ST(6) TB_ST(7) TB_ST(8) TB_ST(9) TB_ST(10) TB_ST(11) TB_ST(12) TB_ST(13) TB_ST(14) TB_ST(15) TB_ST(16) TB_ST(17) TB_ST(18) TB_ST(19) TB_ST(20) TB_ST(21) TB_ST(22) TB_ST(23) TB_ST(24) TB_ST(25)
#undef TB_ST
    }
    __syncthreads();
    const int lo = args.ph_lo, hi = args.ph_hi;
    XcdBarrier bar; bar.bar = (unsigned*)(ws0 + WS_CTL) + CW_BAR; bar.x = 0; bar.st = nullptr;
    if (hi - lo > 1) bar = xcd_barrier_post((unsigned*)(ws0 + WS_CTL) + CW_BAR, MISC + 8);
#ifndef PHMASK
#define PHMASK 0xFFFFFFFFu
#endif
#ifndef DBLMASK
#define DBLMASK 0u
#endif
#define PH_BEGIN(k, kb) if (((PHMASK >> (kb)) & 1u) && lo <= (k) && (k) < hi) { for (int rep_ = 0; rep_ < ((((DBLMASK) >> (kb)) & 1u) ? 2 : 1); ++rep_) { int tid = tid0; asm volatile("" : "+v"(tid)); const int lane = tid & 63, wave = __builtin_amdgcn_readfirstlane(tid >> 6); const int gw = vcu * 8 + wave; \
    size_t zo = 0; asm volatile("" : "+s"(zo)); unsigned char* ws = ws0 + zo; float* X = (float*)(ws + WS_X); bf16* HN = (bf16*)(ws + WS_HN); bf16* HID = (bf16*)(ws + WS_HID); const float* MOD = (const float*)(ws + WS_MOD); unsigned char* act = ws + WS_ACT; const float* modl = MOD + (size_t)layer * 3 * 12288; (void)X; (void)HN; (void)HID; (void)act; (void)modl; (void)lane; (void)gw;
#define PH_END(k)   } if ((k) + 1 < hi) xcd_barrier(bar); }

    int layer = 0;

    PH_BEGIN(0, 0) prologue_phase(TBL, ws, lds, tid, lane, wave, gw, NGW); PH_END(0)
    PH_BEGIN(1, 1) modreduce_phase(TBL, ws, vcu * 512 + tid, G * 512); PH_END(1)

#pragma unroll 1
    for (layer = 0; layer < DEPTH; ++layer) {
        const int kind = layer % 3, jj = layer / 3, pb = 2 + 8 * layer; const bool last = (layer == DEPTH - 1);
        PH_BEGIN(pb + 0, 2) norm_phase(lds, tid, lane, gw, NGW, X, HN, INP(I_NMG) + layer * DM, modl, 0, 2048, false, (const float*)(ws + WS_SLAB), layer > 0 ? 11 : 0, modl - 3 * 12288 + 2 * 12288 + 5 * 2048); PH_END(pb + 0)
        size_t mixAoff, mixWoff; int mixK;
        if (kind == 0) {
#define DA_PTRS bf16 *Qd = (bf16*)act, *Kd = (bf16*)(act + A34), *Vd = (bf16*)(act + 2 * A34); float* OF = (float*)(act + 3 * A34); bf16* DAO = (bf16*)(act + 7 * A34); (void)Qd; (void)Kd; (void)Vd; (void)OF; (void)DAO;
            PH_BEGIN(pb + 1, 3) { DA_PTRS pg8::EpiQkvDa E{Qd, Kd, Vd, (const float*)(ws + WS_RCDA), (const float*)(ws + WS_RSDA)};
                run_gemm(tid, lds, G, HN, (const bf16*)(ws + WS_WQKV + (size_t)jj * 24 * MiB), 6144, 2048, false, E); } PH_END(pb + 1)
            PH_BEGIN(pb + 2, 4) { DA_PTRS da_attn_phase((char*)lds_raw, tid, vcu, G, Qd, Kd, Vd, OF, !last); } PH_END(pb + 2)
            PH_BEGIN(pb + 3, 5) { DA_PTRS da_combine_phase(lane, gw, NGW, OF, DAO, INP(I_DALAM) + jj * 512, INP(I_DASUB) + jj * 256, 0.8f - 0.6f * expf(-0.3f * (float)layer), !last); } PH_END(pb + 3)
            mixAoff = WS_ACT + 7 * A34; mixWoff = WS_WODA + (size_t)jj * 8 * MiB; mixK = 2048;
        } else if (kind == 1) {
#define SG_PTRS bf16 *Ud = (bf16*)act, *Vd = (bf16*)(act + A34), *Gd = (bf16*)(act + 2 * A34); float* VSS = (float*)(ws + WS_VSS); (void)Ud; (void)Vd; (void)Gd; (void)VSS;
            PH_BEGIN(pb + 1, 6) { SG_PTRS pg8::EpiSgIn E{Ud, Vd, VSS}; run_gemm(tid, lds, G, HN, (const bf16*)(ws + WS_WSGI), 4096, 2048, false, E); } PH_END(pb + 1)
            PH_BEGIN(pb + 2, 7) { SG_PTRS sg_phase(lds, tid, lane, wave, vcu, G, Ud, Vd, VSS, INP(I_SGWS), INP(I_SGBS), INP(I_SGVG), Gd); } PH_END(pb + 2)
            mixAoff = WS_ACT + 2 * A34; mixWoff = WS_WSGO; mixK = 2048;
        } else {
#define RT_PTRS bf16 *Qd = (bf16*)act, *Kd = (bf16*)(act + A34), *Vd = (bf16*)(act + 2 * A34), *Gt = (bf16*)(act + 4 * A34), *SBUF = (bf16*)(act + 6 * A34), *RO = (bf16*)(act + 14 * A34); (void)Qd; (void)Kd; (void)Vd; (void)Gt; (void)SBUF; (void)RO;
            PH_BEGIN(pb + 1, 8) { RT_PTRS pg8::EpiRet E{Qd, Kd, Vd, Gt, (const float*)(ws + WS_RCRT), (const float*)(ws + WS_RSRT)}; run_gemm(tid, lds, G, HN, (const bf16*)(ws + WS_WRET), 12288, 2048, false, E); } PH_END(pb + 1)
            PH_BEGIN(pb + 2, 9) { RT_PTRS ret_state_phase(lds, tid, lane, wave, vcu, G, Kd, Vd, SBUF, INP(I_RDEC)); } PH_END(pb + 2)
            PH_BEGIN(pb + 3, 10) { RT_PTRS ret_out_phase(lds, tid, lane, wave, vcu, G, Qd, Kd, Vd, SBUF, Gt, RO, INP(I_RDEC)); } PH_END(pb + 3)
            mixAoff = WS_ACT + 14 * A34; mixWoff = WS_WRETO; mixK = 4096;
        }
        PH_BEGIN(pb + 4, 11) { pg8::EpiRes E{X, modl, 2 * 2048, (float*)(ws + WS_SLAB), rep_ == 0 ? 1.0f : 0.0f}; run_gemm(tid, lds, G, (const bf16*)(ws + mixAoff), (const bf16*)(ws + mixWoff), 2048, mixK, last, E, last ? 0 : 8, mixK / 512); } PH_END(pb + 4)
        PH_BEGIN(pb + 5, 2) norm_phase(lds, tid, lane, gw, NGW, X, HN, INP(I_NFG) + layer * DM, modl, 3 * 2048, 4 * 2048, last, (const float*)(ws + WS_SLAB), last ? 0 : 8, modl + 2 * 12288 + 2 * 2048); PH_END(pb + 5)
        PH_BEGIN(pb + 6, 12) { pg8::EpiSwiglu E{HID}; run_gemm(tid, lds, G, HN, (const bf16*)(ws + WS_WGU + (size_t)layer * 44 * MiB), 11264, 2048, last, E); } PH_END(pb + 6)
        PH_BEGIN(pb + 7, 13) { pg8::EpiRes E{X, modl, 5 * 2048, (float*)(ws + WS_SLAB), rep_ == 0 ? 1.0f : 0.0f}; run_gemm(tid, lds, G, HID, (const bf16*)(ws + WS_WD + (size_t)layer * 22 * MiB), 2048, FFH, last, E, last ? 0 : 11, 8); } PH_END(pb + 7)
    }
    PH_BEGIN(N_PHASES - 1, 14) final_norm_phase(lane, gw, NGW, X, args.out, INP(I_FNG)); PH_END(N_PHASES - 1)
#undef PH_BEGIN
#undef PH_END
}

#ifndef ONE_LAUNCH
#define ONE_LAUNCH 1
#endif
extern "C" void kernel_launch(void* const* d_in, const int* in_sizes, int n_in, void* d_out, int out_size, void* d_ws, size_t ws_size, hipStream_t stream) {
    static int grid = 0;
    if (grid == 0) {
        if (n_in != 26 || out_size != NB * SEQ * DM || ws_size < WS_END) { fprintf(stderr, "kernel_launch: unexpected shapes (n_in %d, out %d, ws %zu < %zu)\n", n_in, out_size, ws_size, (size_t)WS_END); grid = -1; return; }
        int dev = 0, cus = 0;
        if (hipGetDevice(&dev) != hipSuccess || hipDeviceGetAttribute(&cus, hipDeviceAttributeMultiprocessorCount, dev) != hipSuccess) { grid = -1; return; }
        if (hipFuncSetAttribute((const void*)fwd_kernel, hipFuncAttributeMaxDynamicSharedMemorySize, LDS_BYTES) != hipSuccess) { fprintf(stderr, "kernel_launch: hipFuncSetAttribute failed\n"); grid = -1; return; }
        grid = cus;
    }
    if (grid < 0) return;
    (void)hipMemsetAsync((char*)d_ws + WS_CTL, 0, CTL_ZERO_BYTES, stream);
    Args a{};
    for (int i = 0; i < 26; ++i) a.in[i] = (const float*)d_in[i];
    a.out = (float*)d_out; a.ws = (unsigned char*)d_ws;
#if ONE_LAUNCH
    a.ph_lo = 0; a.ph_hi = N_PHASES;
    hipLaunchKernelGGL(fwd_kernel, dim3(grid), dim3(512), LDS_BYTES, stream, a);
#else
    for (int p = 0; p < N_PHASES; ++p) {
        if (p == 2 + 8 * 1 + 3) continue;
        a.ph_lo = p; a.ph_hi = p + 1;
        hipLaunchKernelGGL(fwd_kernel, dim3(grid), dim3(512), LDS_BYTES, stream, a);
    }
#endif
}
```
